# Optimizing an MI355X kernel written in HIP

```python
import math
import jax, jax.numpy as jnp
from jax import lax
import numpy as np

D_MODEL = 4096
BATCH = 2
SEQ = 8192
DEPTH = 1

PLE_DIM = 256
MIX_WIDTH = D_MODEL
MLA_HEADS = 16
MLA_NOPE = 128
MLA_ROPE = 64
MLA_V = 128
Q_LORA = 1024
KV_LORA = 512
MLA_WIDTH = MLA_HEADS * MLA_V
SWA_HEADS = 32
SWA_KV_HEADS = 4
SWA_HEAD_DIM = 64
SWA_GROUP = SWA_HEADS // SWA_KV_HEADS
SWA_WIDTH = SWA_HEADS * SWA_HEAD_DIM
WINDOW = 128
BLOCK = 128
ROPE_THETA = 10000.0
NORM_EPS = 1e-6
D_FF = ((8 * D_MODEL + 3 * 256 - 1) // (3 * 256)) * 256
IN_SIZES = (Q_LORA, KV_LORA, MLA_ROPE, SWA_HEADS * SWA_HEAD_DIM,
            SWA_KV_HEADS * SWA_HEAD_DIM, SWA_KV_HEADS * SWA_HEAD_DIM)
IN_SPLITS = tuple(int(v) for v in np.cumsum(IN_SIZES)[:-1])
D_IN = sum(IN_SIZES)

kernel_name = "hymba_mla_swa_sink_alibi_sandwich_ple"


def rmsnorm(x, g):
    xf = x.astype(jnp.float32)
    xf = xf * lax.rsqrt(jnp.mean(xf * xf, axis=-1, keepdims=True) + NORM_EPS)
    return (xf * g.astype(jnp.float32)).astype(x.dtype)


def rope(x, pos):
    d = x.shape[-1]
    inv_freq = ROPE_THETA ** (-jnp.arange(0, d, 2, dtype=jnp.float32) / d)
    ang = pos.astype(jnp.float32)[..., None] * inv_freq
    cos = jnp.cos(ang)[:, :, None, :].astype(x.dtype)
    sin = jnp.sin(ang)[:, :, None, :].astype(x.dtype)
    x1, x2 = x[..., : d // 2], x[..., d // 2:]
    return jnp.concatenate([x1 * cos - x2 * sin, x1 * sin + x2 * cos], axis=-1)


def alibi_slopes(n_heads):
    return 2.0 ** (-8.0 * jnp.arange(1, n_heads + 1, dtype=jnp.float32) / n_heads)


def mla_attention(q_nope, q_rope, k_nope, k_rope, v):
    B, S, H, _ = q_nope.shape
    nblk = S // BLOCK
    scale = 1.0 / math.sqrt(MLA_NOPE + MLA_ROPE)
    qn = q_nope.reshape(B, nblk, BLOCK, H, MLA_NOPE).transpose(1, 0, 2, 3, 4)
    qr = q_rope.reshape(B, nblk, BLOCK, H, MLA_ROPE).transpose(1, 0, 2, 3, 4)
    k_idx = jnp.arange(S)

    def one_block(args):
        blk, qn_b, qr_b = args
        s = (jnp.einsum('bqhd,bkhd->bhqk', qn_b, k_nope)
             + jnp.einsum('bqhd,bkd->bhqk', qr_b, k_rope)).astype(jnp.float32) * scale
        q_idx = blk * BLOCK + jnp.arange(BLOCK)
        causal = q_idx[:, None] >= k_idx[None, :]
        s = jnp.where(causal[None, None], s, -jnp.inf)
        pr = jax.nn.softmax(s, axis=-1).astype(v.dtype)
        return jnp.einsum('bhqk,bkhd->bqhd', pr, v)

    out = lax.map(one_block, (jnp.arange(nblk), qn, qr))
    return out.transpose(1, 0, 2, 3, 4).reshape(B, S, H * MLA_V)


def band(t, nblk):
    B = t.shape[0]
    tb = t.reshape(B, nblk, BLOCK, *t.shape[2:])
    prev = jnp.concatenate([jnp.zeros_like(tb[:, :1]), tb[:, :-1]], axis=1)
    return jnp.concatenate([prev, tb], axis=2)


def swa_attention(q, k, v, sinks, pos):
    B, S = q.shape[:2]
    nblk = S // BLOCK
    scale = 1.0 / math.sqrt(SWA_HEAD_DIM)
    qb = q.reshape(B, nblk, BLOCK, SWA_KV_HEADS, SWA_GROUP, SWA_HEAD_DIM)
    kb, vb = band(k, nblk), band(v, nblk)
    pq = pos.reshape(B, nblk, BLOCK).astype(jnp.float32)
    pk = band(pos, nblk).astype(jnp.float32)
    q_loc = BLOCK + jnp.arange(BLOCK)
    k_loc = jnp.arange(2 * BLOCK)
    rel = q_loc[:, None] - k_loc[None, :]
    in_window = (rel >= 0) & (rel < WINDOW)
    not_pad = (jnp.arange(nblk)[:, None, None] > 0) | (k_loc[None, None, :] >= BLOCK)
    valid = in_window[None] & not_pad
    s = jnp.einsum('bnqhgd,bnkhd->bnhgqk', qb, kb).astype(jnp.float32) * scale
    dist = jnp.abs(pq[..., :, None] - pk[..., None, :])
    slopes = alibi_slopes(SWA_HEADS).reshape(SWA_KV_HEADS, SWA_GROUP)
    s = s - slopes[None, None, :, :, None, None] * dist[:, :, None, None]
    s = jnp.where(valid[None, :, None, None], s, -jnp.inf)
    sink = jnp.broadcast_to(sinks.astype(jnp.float32).reshape(1, 1, SWA_KV_HEADS, SWA_GROUP, 1, 1),
                            s.shape[:-1] + (1,))
    pr = jax.nn.softmax(jnp.concatenate([s, sink], axis=-1), axis=-1)[..., :-1]
    out = jnp.einsum('bnhgqk,bnkhd->bnqhgd', pr.astype(v.dtype), vb)
    return out.reshape(B, S, SWA_WIDTH)


def setup_inputs(seed: int = 0) -> dict:
    key = jax.random.key(seed)
    ks = jax.random.split(key, 21)
    f32 = jnp.float32

    def w(k, shape, fan_in):
        return jax.random.normal(k, shape, f32) * fan_in ** -0.5

    def gain(k, n):
        return 1.0 + 0.05 * jax.random.normal(k, (DEPTH, n), f32)

    return {
        "x": jax.random.normal(ks[0], (BATCH, SEQ, D_MODEL), f32),
        "p": jax.random.normal(ks[1], (DEPTH, BATCH, SEQ, PLE_DIM), f32),
        "positions": jnp.broadcast_to(jnp.arange(SEQ, dtype=jnp.int32), (BATCH, SEQ)),
        "attn_pre_norm": gain(ks[2], D_MODEL),
        "w_in": w(ks[3], (DEPTH, D_MODEL, D_IN), D_MODEL),
        "q_a_norm": gain(ks[4], Q_LORA),
        "w_q_up": w(ks[5], (DEPTH, Q_LORA, MLA_HEADS * (MLA_NOPE + MLA_ROPE)), Q_LORA),
        "kv_a_norm": gain(ks[6], KV_LORA),
        "w_kv_up": w(ks[7], (DEPTH, KV_LORA, MLA_HEADS * (MLA_NOPE + MLA_V)), KV_LORA),
        "sinks": 0.5 * jax.random.normal(ks[8], (DEPTH, SWA_HEADS), f32),
        "mla_out_norm": gain(ks[9], MLA_WIDTH),
        "swa_out_norm": gain(ks[10], SWA_WIDTH),
        "w_o": w(ks[11], (DEPTH, MIX_WIDTH, D_MODEL), MIX_WIDTH),
        "attn_post_norm": gain(ks[12], D_MODEL),
        "ffn_pre_norm": gain(ks[13], D_MODEL),
        "w_gate": w(ks[14], (DEPTH, D_MODEL, D_FF), D_MODEL),
        "w_up": w(ks[15], (DEPTH, D_MODEL, D_FF), D_MODEL),
        "w_down": w(ks[16], (DEPTH, D_FF, D_MODEL), D_FF),
        "ffn_post_norm": gain(ks[17], D_MODEL),
        "w_ple_gate": w(ks[18], (DEPTH, D_MODEL, D_MODEL), D_MODEL),
        "w_ple_proj": w(ks[19], (DEPTH, PLE_DIM, D_MODEL), PLE_DIM),
    }


def reference(x, p, positions, attn_pre_norm, w_in, q_a_norm, w_q_up, kv_a_norm, w_kv_up,
              sinks, mla_out_norm, swa_out_norm, w_o, attn_post_norm, ffn_pre_norm,
              w_gate, w_up, w_down, ffn_post_norm, w_ple_gate, w_ple_proj):
    B, S, _ = x.shape
    for i in range(DEPTH):
        h = rmsnorm(x, attn_pre_norm[i])
        proj = h @ w_in[i]
        c_q, c_kv, k_rope, q_swa, k_swa, v_swa = jnp.split(proj, IN_SPLITS, axis=-1)

        q = (rmsnorm(c_q, q_a_norm[i]) @ w_q_up[i]).reshape(B, S, MLA_HEADS, MLA_NOPE + MLA_ROPE)
        kv = (rmsnorm(c_kv, kv_a_norm[i]) @ w_kv_up[i]).reshape(B, S, MLA_HEADS, MLA_NOPE + MLA_V)
        q_nope, q_rope = q[..., :MLA_NOPE], rope(q[..., MLA_NOPE:], positions)
        k_nope, v_mla = kv[..., :MLA_NOPE], kv[..., MLA_NOPE:]
        k_rope = rope(k_rope[:, :, None, :], positions)[:, :, 0]
        o_mla = mla_attention(q_nope, q_rope, k_nope, k_rope, v_mla)

        o_swa = swa_attention(q_swa.reshape(B, S, SWA_HEADS, SWA_HEAD_DIM),
                              k_swa.reshape(B, S, SWA_KV_HEADS, SWA_HEAD_DIM),
                              v_swa.reshape(B, S, SWA_KV_HEADS, SWA_HEAD_DIM),
                              sinks[i], positions)

        mixed = jnp.concatenate([rmsnorm(o_mla, mla_out_norm[i]),
                                 rmsnorm(o_swa, swa_out_norm[i])], axis=-1)
        x = x + rmsnorm(mixed @ w_o[i], attn_post_norm[i])

        h = rmsnorm(x, ffn_pre_norm[i])
        f = (jax.nn.silu(h @ w_gate[i]) * (h @ w_up[i])) @ w_down[i]
        x = x + rmsnorm(f, ffn_post_norm[i])

        gate = jax.nn.sigmoid(x @ w_ple_gate[i])
        x = x + gate * (p[i] @ w_ple_proj[i])
    return x
```

```cpp
#include <hip/hip_runtime.h>
#include <hip/hip_cooperative_groups.h>
#include <cstdio>
#include <cstdint>
namespace cg = cooperative_groups;

#ifndef PROBE_PH
#define PROBE_PH -1
#define PROBE_N 1
#endif
#ifndef MK_SINGLE
#define MK_SINGLE 1
#endif

#define DI __device__ __forceinline__
#define LAS __attribute__((address_space(3)))
typedef unsigned short bf16_t;
typedef short bf16x8 __attribute__((ext_vector_type(8)));
typedef float f32x4 __attribute__((ext_vector_type(4)));
typedef float f32x2 __attribute__((ext_vector_type(2)));
typedef float f32x16 __attribute__((ext_vector_type(16)));
typedef unsigned u32x4 __attribute__((ext_vector_type(4)));
typedef unsigned u32x2 __attribute__((ext_vector_type(2)));
typedef __bf16 bf16x2_t __attribute__((ext_vector_type(2)));

constexpr int NB = 2, S = 8192, T = NB * S, D = 4096, DFF = 11008, PLE = 256;
constexpr int DIN_P = 4352;
constexpr int QW = 3072, KNW = 2048;
constexpr float EPS = 1e-6f;
constexpr float LOG2E = 1.4426950408889634f;
constexpr float MLA_QSCALE = 0.10411754627697264f;
constexpr float SWA_QSCALE = 0.18033688011112042f;
constexpr int LDS_BYTES = 163840;
constexpr int VPITCH = S + 128;

constexpr int PJ_CQ = 0, PJ_CKV = 1024, PJ_QS = 1536, PJ_KS = 3584, PJ_VS = 3840, PJ_KR = 4096;

constexpr size_t al256(size_t x) { return (x + 255) & ~(size_t)255; }
constexpr size_t WS_WIN = 0;
constexpr size_t WS_WQUP = WS_WIN + (size_t)DIN_P * D * 2;
constexpr size_t WS_WKVUP = WS_WQUP + (size_t)QW * 1024 * 2;
constexpr size_t WS_WO = WS_WKVUP + (size_t)4096 * 512 * 2;
constexpr size_t WS_WGU = WS_WO + (size_t)D * D * 2;
constexpr size_t WS_WDN = WS_WGU + (size_t)2 * DFF * D * 2;
constexpr size_t WS_WPG = WS_WDN + (size_t)D * DFF * 2;
constexpr size_t WS_WPP = WS_WPG + (size_t)D * D * 2;
constexpr size_t WS_CS = WS_WPP + (size_t)D * PLE * 2;
constexpr size_t WS_SSQ = WS_CS + (size_t)T * 32 * 8;
constexpr size_t WS_PB = WS_SSQ + (size_t)12 * T * 4;
constexpr size_t WS_KR = WS_PB + (size_t)T * PLE * 2;
constexpr size_t WS_KRP = WS_KR + 16384;
constexpr size_t WS_VTS = WS_KRP + (size_t)4 * T * 64 * 4;
constexpr size_t WS_R0 = al256(WS_VTS + (size_t)NB * 4 * 64 * VPITCH * 2);
constexpr size_t WS_B = WS_R0 + (size_t)T * D * 2;
constexpr size_t WS_PROJ = WS_B;
constexpr size_t WS_Q = WS_PROJ + (size_t)T * DIN_P * 2;
constexpr size_t WS_KN = WS_Q + (size_t)T * QW * 2;
constexpr size_t WS_VT = WS_KN + (size_t)T * 3072 * 2;
constexpr size_t WS_VT_END = WS_VT + (size_t)NB * 2048 * VPITCH * 2;
constexpr size_t WS_Y = WS_B;
constexpr size_t WS_TOTAL = (size_t)1 << 30;
constexpr size_t WS_ACT = WS_TOTAL - (size_t)T * DFF * 2;
constexpr size_t WS_F = WS_R0;
constexpr size_t WS_X2B = WS_ACT;
constexpr size_t WS_PP = WS_B;
static_assert(WS_VT_END <= WS_TOTAL, "ws");
static_assert(WS_Y + (size_t)T * D * 4 <= WS_TOTAL, "ws");
static_assert(WS_F + (size_t)T * D * 4 <= WS_ACT, "ws");
static_assert(WS_R0 + (size_t)T * D * 2 <= WS_ACT, "ws");
static_assert(WS_PP + (size_t)T * D * 2 <= WS_ACT, "ws");

DI unsigned pk2(float a, float b) { f32x2 v = {a, b}; return __builtin_bit_cast(unsigned, __builtin_convertvector(v, bf16x2_t)); }
DI bf16_t f2bf(float a) { return (bf16_t)(pk2(a, 0.f) & 0xffffu); }
DI float bflo(unsigned u) { return __uint_as_float(u << 16); }
DI float bfhi(unsigned u) { return __uint_as_float(u & 0xffff0000u); }
DI float wave_sum(float v) {
#pragma unroll
    for (int o = 1; o < 64; o <<= 1) v += __shfl_xor(v, o);
    return v;
}
DI float fast_exp2(float x) { return __builtin_amdgcn_exp2f(x); }
DI float fast_rcp(float x) { return __builtin_amdgcn_rcpf(x); }
DI float sigmoidf_(float v) { return fast_rcp(1.0f + fast_exp2(-v * LOG2E)); }
DI int my_tid() { int t = threadIdx.x; asm volatile("" : "+v"(t)); return t; }
DI float xhalf_max(float v) { const auto r = __builtin_amdgcn_permlane32_swap(__float_as_uint(v), __float_as_uint(v), false, false); return fmaxf(__uint_as_float(r[0]), __uint_as_float(r[1])); }
DI const unsigned char* uni_ptr(const unsigned char* p) { const unsigned long long v = (unsigned long long)p; const unsigned lo = __builtin_amdgcn_readfirstlane((unsigned)v), hi = __builtin_amdgcn_readfirstlane((unsigned)(v >> 32)); return (const unsigned char*)(((unsigned long long)hi << 32) | lo); }
DI void dma16(const unsigned char* sbase, unsigned voff, unsigned ldsaddr) { asm volatile("s_mov_b32 m0, %0\n\ts_nop 0\n\tglobal_load_lds_dwordx4 %1, %2" :: "s"(ldsaddr), "v"(voff), "s"(sbase) : "memory"); }
DI int pi32(int i) { return (i & ~12) | ((i & 4) << 1) | ((i & 8) >> 1); }


#define XB_TMO      128
#define XB_XCNT(j)  (256  + 64 * (j))
#define XB_XSUB(j)  (1280 + 64 * (j))
#define XB_XGEN(j)  (2304 + 64 * (j))
#define XB_TOP      3328
#define XB_TOPGEN   3392
#define XB_SLOT(w)  (3456 + 2 * (w))
#define XB_WORDS    4096
#define XB_SPIN_CAP (1u << 20)
DI unsigned xb_ld(unsigned* p) { return __hip_atomic_load(p, __ATOMIC_RELAXED, __HIP_MEMORY_SCOPE_AGENT); }
DI unsigned xb_add(unsigned* p, unsigned v) { return __hip_atomic_fetch_add(p, v, __ATOMIC_RELAXED, __HIP_MEMORY_SCOPE_AGENT); }
DI unsigned xb_xcc_id() { return (unsigned)__builtin_amdgcn_s_getreg((3 << 11) | 20) & 0xFu; }
#define XB_SPIN(cond, bar) do { unsigned _sp = 0; while (cond) { __builtin_amdgcn_s_sleep(1); \
    if ((++_sp & 255u) == 0u) { if (xb_ld(&(bar)[XB_TMO])) break; if (_sp > XB_SPIN_CAP) { xb_add(&(bar)[XB_TMO], 1u); break; } } } } while (0)
DI void xcd_barrier_post(unsigned* bar) { if (threadIdx.x == 0) (void)xb_add(&bar[XB_XCNT(xb_xcc_id())], 1u); }
DI void xcd_barrier(unsigned* bar) {
    asm volatile("s_waitcnt vmcnt(0) lgkmcnt(0)" ::: "memory");
    __syncthreads();
    if (threadIdx.x == 0) {
        const unsigned x = xb_xcc_id(), G = gridDim.x;
        unsigned nloc = xb_ld(&bar[XB_SLOT(blockIdx.x)]), nx = xb_ld(&bar[XB_SLOT(blockIdx.x) + 1]);
        if (nloc == 0u) {
            unsigned sum, cnt, mine, sp = 0u;
            for (;;) {
                sum = 0u; cnt = 0u; mine = 0u;
#pragma unroll
                for (unsigned j = 0; j < 16; ++j) { const unsigned c = xb_ld(&bar[XB_XCNT(j)]); sum += c; cnt += (c > 0u) ? 1u : 0u; mine = (j == x) ? c : mine; }
                if (sum == G) break;
                __builtin_amdgcn_s_sleep(1);
                if ((++sp & 255u) == 0u) { if (xb_ld(&bar[XB_TMO])) break; if (sp > XB_SPIN_CAP) { xb_add(&bar[XB_TMO], 1u); break; } }
            }
            nloc = mine > 0u ? mine : 1u; nx = cnt > 0u ? cnt : 1u;
            __hip_atomic_store(&bar[XB_SLOT(blockIdx.x)], nloc, __ATOMIC_RELAXED, __HIP_MEMORY_SCOPE_AGENT); __hip_atomic_store(&bar[XB_SLOT(blockIdx.x) + 1], nx, __ATOMIC_RELAXED, __HIP_MEMORY_SCOPE_AGENT);
        }
        const unsigned old = xb_add(&bar[XB_XSUB(x)], 1u);
        const unsigned gen = old / nloc;
        if (old + 1u == (gen + 1u) * nloc) {
            __builtin_amdgcn_fence(__ATOMIC_RELEASE, "agent");
            asm volatile("s_waitcnt vmcnt(0)" ::: "memory");
            const unsigned og = xb_add(&bar[XB_TOP], 1u);
            const unsigned tg = og / nx;
            if (og + 1u == (tg + 1u) * nx) xb_add(&bar[XB_TOPGEN], 1u);
            else XB_SPIN(xb_ld(&bar[XB_TOPGEN]) == tg, bar);
            __builtin_amdgcn_fence(__ATOMIC_ACQUIRE, "agent");
            xb_add(&bar[XB_XGEN(x)], 1u);
            asm volatile("s_waitcnt vmcnt(0)" ::: "memory");
        } else {
            XB_SPIN(xb_ld(&bar[XB_XGEN(x)]) == gen, bar);
            __builtin_amdgcn_fence(__ATOMIC_ACQUIRE, "agent");
            asm volatile("s_waitcnt vmcnt(0)" ::: "memory");
        }
    }
    __syncthreads();
}

namespace pg8 {
constexpr int BM = 256, BK = 64, HALF = 128, HTB = HALF * BK * 2, STAGE_BYTES = 8 * HTB, NXCD = 8, WGM = 8;
DI int lds_byte(int r, int c) { const int st = (r >> 4) * 2 + (c >> 5), rr = r & 15, cc = c & 31, ob = rr * 64 + cc * 2; return st * 1024 + (ob ^ (((ob >> 9) & 1) << 5)); }
DI void stage_rc(int b, int& R, int& C) { const int st = b / 1024, sb = b % 1024, swz = sb ^ (((sb >> 9) & 1) << 5); R = (st >> 1) * 16 + swz / 64; C = (st & 1) * 32 + (swz % 64) / 2; }
DI int perm32(int rho) { const int n = rho >> 4, i = rho & 15; return 8 * (i >> 2) + 4 * n + (i & 3); }

struct Unit { int pm, pn, half; };
struct Gemm { const bf16_t* A; const bf16_t* Bt; int M, N, K, lda, ldb; };

struct StaticOrder {
    int nM, nN, nwg, G, c, split;
    DI void init(int M, int N, int G_, int c_, int split_ = 0) { nM = M / BM; nN = N / BM; nwg = nM * nN; G = G_; c = c_; split = split_; }
    DI bool next(int i, Unit& u) const {
        if (split == 2) { const long L4 = (long)i * G + c; if (L4 >= 4L * nM) return false; u.pm = (int)(L4 >> 2); u.pn = 0; u.half = (int)(L4 & 3); return true; }
        u.half = split ? (i & 1) : 1; if (split) i >>= 1;
        const long L = (long)i * G + c; if (L >= nwg) return false;
        int wgid = (int)L; { const int q = nwg / NXCD, r = nwg % NXCD, xcd = wgid % NXCD, off = wgid / NXCD; wgid = (xcd < r ? xcd * (q + 1) : r * (q + 1) + (xcd - r) * q) + off; }
        const int nig = WGM * nN, gid = wgid / nig, fm = gid * WGM, gsz = (nM - fm) < WGM ? (nM - fm) : WGM;
        u.pm = fm + ((wgid % nig) % gsz); u.pn = (wgid % nig) / gsz; return true;
    }
};

template <class Epi>
DI void gemm_phase(LAS unsigned char* lds, const Gemm g, const StaticOrder& S, const Epi& E) {
    const int tid = my_tid(), wid = __builtin_amdgcn_readfirstlane(tid >> 6), lane = tid & 63, wr = wid >> 2, wc = wid & 3, fr = lane & 15, fq = lane >> 4;
    int K = g.K; asm volatile("" : "+s"(K));
    const int nt = K / BK;
    unsigned voffA[2], voffB[2];
#pragma unroll
    for (int i = 0; i < 2; ++i) { int R, C; stage_rc(tid * 16 + i * 8192, R, C); const int Rb = Epi::PERM ? ((R & ~31) + perm32(R & 31)) : R;
        voffA[i] = (unsigned)(R * g.lda + C) * 2u; voffB[i] = (unsigned)(Rb * g.ldb + C) * 2u; }
    const size_t kstep = (size_t)(BK * 2);
    const size_t hstepA = (size_t)HALF * g.lda * 2, hstepB = (size_t)HALF * g.ldb * 2;
    const size_t tstepA = 2 * hstepA, tstepB = 2 * hstepB;
    const unsigned ldsw = (unsigned)wid * 1024u;
    const int aoff = lds_byte(wr * 64 + fr, fq * 8), boff = lds_byte(wc * 32 + fr, fq * 8);
#define PG8_SA(b, h) (((b) * 2 + (h)) * HTB)
#define PG8_SB(b, h) ((4 + (b) * 2 + (h)) * HTB)
#define PG8_STAGE(bufoff, gbase, voff) do { _Pragma("unroll") for (int _i = 0; _i < 2; ++_i) \
        __builtin_amdgcn_global_load_lds((const unsigned*)((const char*)(gbase) + (voff)[_i]), (LAS unsigned*)(lds + (bufoff) + ldsw + _i * 8192), 16, 0, 0); } while (0)
#define PG8_LDA(dst, b, h) do { _Pragma("unroll") for (int m = 0; m < 4; ++m) _Pragma("unroll") for (int k = 0; k < 2; ++k) dst[m][k] = *(const LAS bf16x8*)(lds + PG8_SA(b, h) + aoff + m * 2048 + k * 1024); } while (0)
#define PG8_LDB(dst, b, h) do { _Pragma("unroll") for (int n = 0; n < 2; ++n) _Pragma("unroll") for (int k = 0; k < 2; ++k) dst[n][k] = *(const LAS bf16x8*)(lds + PG8_SB(b, h) + boff + n * 2048 + k * 1024); } while (0)
#define PG8_MMA(ai, bj, At, Bt) do { __builtin_amdgcn_s_setprio(1); _Pragma("unroll") for (int m = 0; m < 4; ++m) _Pragma("unroll") for (int n = 0; n < 2; ++n) _Pragma("unroll") for (int k = 0; k < 2; ++k) \
        acc[ai][bj][m][n] = __builtin_amdgcn_mfma_f32_16x16x32_bf16(Bt[n][k], At[m][k], acc[ai][bj][m][n], 0, 0, 0); __builtin_amdgcn_s_setprio(0); } while (0)
#define PG8_WAIT_V(n) asm volatile("s_waitcnt vmcnt(" #n ")" ::: "memory")
#define PG8_WAIT_L(n) asm volatile("s_waitcnt lgkmcnt(" #n ")" ::: "memory")
#define PG8_BAR __builtin_amdgcn_s_barrier()
#define PG8_SCHED __builtin_amdgcn_sched_barrier(0)
    Unit cur, nxt; int ui = 0;
    if (!S.next(0, cur)) return;
    f32x4 acc[2][2][4][2];
#pragma unroll
    for (int a = 0; a < 2; ++a)
#pragma unroll
        for (int b = 0; b < 2; ++b)
#pragma unroll
            for (int m = 0; m < 4; ++m)
#pragma unroll
                for (int n = 0; n < 2; ++n) acc[a][b][m][n] = (f32x4){0.f, 0.f, 0.f, 0.f};
    bf16x8 At[4][2], B0[2][2], B1[2][2];
#define PG8_KOFF(u) ((Epi::MIDK || Epi::KSPLIT) ? (size_t)(u).half * (size_t)K * 2 : (size_t)0)
    const char* cA = (const char*)g.A + (size_t)cur.pm * tstepA + PG8_KOFF(cur); const char* cB = (const char*)g.Bt + (size_t)cur.pn * tstepB + PG8_KOFF(cur);
    PG8_STAGE(PG8_SB(0, 0), cB, voffB); PG8_STAGE(PG8_SB(0, 1), cB + hstepB, voffB); PG8_STAGE(PG8_SA(0, 0), cA, voffA); PG8_STAGE(PG8_SA(0, 1), cA + hstepA, voffA);
    if (wr == 1) PG8_BAR;
    PG8_WAIT_V(2); PG8_BAR;
    PG8_STAGE(PG8_SB(1, 0), cB + kstep, voffB); PG8_STAGE(PG8_SA(1, 0), cA + kstep, voffA); PG8_STAGE(PG8_SB(1, 1), cB + hstepB + kstep, voffB);
    PG8_WAIT_V(6); PG8_BAR;
    for (;;) {
        const bool has_next = S.next(ui + 1, nxt);
        const char* nA = has_next ? (const char*)g.A + (size_t)nxt.pm * tstepA + PG8_KOFF(nxt) : cA; const char* nB = has_next ? (const char*)g.Bt + (size_t)nxt.pn * tstepB + PG8_KOFF(nxt) : cB;
        for (int t = 0; t < nt; t += 2) {
            const bool last = (t == nt - 2);
            const char* a1 = cA + (size_t)(t + 1) * kstep;
            const char* a2 = last ? nA : cA + (size_t)(t + 2) * kstep; const char* b2 = last ? nB : cB + (size_t)(t + 2) * kstep;
            const char* a3 = a2 + kstep; const char* b3 = b2 + kstep;
            PG8_LDB(B0, 0, 0); PG8_LDB(B1, 0, 1); PG8_SCHED; PG8_LDA(At, 0, 0); PG8_STAGE(PG8_SA(1, 1), a1 + hstepA, voffA);
            PG8_WAIT_V(8); PG8_WAIT_L(0); PG8_BAR; PG8_MMA(0, 0, At, B0); PG8_MMA(0, 1, At, B1); PG8_BAR; PG8_SCHED;
            PG8_LDA(At, 0, 1); PG8_STAGE(PG8_SB(0, 0), b2, voffB); PG8_STAGE(PG8_SB(0, 1), b2 + hstepB, voffB); PG8_STAGE(PG8_SA(0, 0), a2, voffA);
            PG8_WAIT_V(8); PG8_WAIT_L(0); PG8_BAR; PG8_MMA(1, 0, At, B0); PG8_MMA(1, 1, At, B1); PG8_BAR; PG8_SCHED;
            PG8_LDB(B0, 1, 0); PG8_LDB(B1, 1, 1); PG8_SCHED; PG8_LDA(At, 1, 0); PG8_STAGE(PG8_SA(0, 1), a2 + hstepA, voffA);
            PG8_WAIT_V(8); PG8_WAIT_L(0); PG8_BAR; PG8_MMA(0, 0, At, B0); PG8_MMA(0, 1, At, B1); PG8_BAR; PG8_SCHED;
            PG8_LDA(At, 1, 1); PG8_STAGE(PG8_SB(1, 0), b3, voffB); PG8_STAGE(PG8_SB(1, 1), b3 + hstepB, voffB); PG8_STAGE(PG8_SA(1, 0), a3, voffA);
            PG8_WAIT_V(8); PG8_WAIT_L(0); PG8_BAR; PG8_MMA(1, 0, At, B0); PG8_MMA(1, 1, At, B1); PG8_BAR; PG8_SCHED;
        }
        if (wr == 0) PG8_BAR;
        bool keep = false;
        if constexpr (Epi::MIDK) { if (cur.half == 0) { E.mid(acc, cur, wr, wc, fr, fq); keep = true; } else E(acc, cur, wr, wc, fr, fq); } else E(acc, cur, wr, wc, fr, fq);
        if (!has_next) break;
        if (!keep)
#pragma unroll
        for (int a = 0; a < 2; ++a)
#pragma unroll
            for (int b = 0; b < 2; ++b)
#pragma unroll
                for (int m = 0; m < 4; ++m)
#pragma unroll
                    for (int n = 0; n < 2; ++n) acc[a][b][m][n] = (f32x4){0.f, 0.f, 0.f, 0.f};
        cur = nxt; cA = nA; cB = nB; ++ui;
        if (wr == 1) PG8_BAR;
    }
    PG8_WAIT_V(0);
    PG8_BAR;
#undef PG8_SA
#undef PG8_KOFF
#undef PG8_SB
#undef PG8_STAGE
#undef PG8_LDA
#undef PG8_LDB
#undef PG8_MMA
#undef PG8_WAIT_V
#undef PG8_WAIT_L
#undef PG8_BAR
#undef PG8_SCHED
}
}
using pg8::Unit;

typedef const f32x4 (&AccRef)[2][2][4][2];

DI float row_sq(AccRef acc, int ai, int m) {
    float s = 0.f;
#pragma unroll
    for (int bj = 0; bj < 2; ++bj)
#pragma unroll
        for (int n = 0; n < 2; ++n) { const f32x4 v = acc[ai][bj][m][n]; s += (v[0] * v[0] + v[1] * v[1]) + (v[2] * v[2] + v[3] * v[3]); }
    { const auto a = __builtin_amdgcn_permlane16_swap(__float_as_uint(s), __float_as_uint(s), false, false); s = __uint_as_float(a[0]) + __uint_as_float(a[1]); }
    { const auto b = __builtin_amdgcn_permlane32_swap(__float_as_uint(s), __float_as_uint(s), false, false); s = __uint_as_float(b[0]) + __uint_as_float(b[1]); }
    return s;
}
DI u32x4 pack8(f32x4 v0, f32x4 v1) { u32x4 w; w.x = pk2(v0[0], v0[1]); w.y = pk2(v0[2], v0[3]); w.z = pk2(v1[0], v1[1]); w.w = pk2(v1[2], v1[3]); return w; }
DI void rope8(f32x4& v0, f32x4& v1, const f32x2* cs) {
    const f32x4 c01 = *(const f32x4*)cs, c23 = *(const f32x4*)(cs + 2);
    f32x4 r0, r1;
    r0[0] = v0[0] * c01[0] - v0[1] * c01[1]; r0[1] = v0[0] * c01[1] + v0[1] * c01[0];
    r0[2] = v0[2] * c01[2] - v0[3] * c01[3]; r0[3] = v0[2] * c01[3] + v0[3] * c01[2];
    r1[0] = v1[0] * c23[0] - v1[1] * c23[1]; r1[1] = v1[0] * c23[1] + v1[1] * c23[0];
    r1[2] = v1[2] * c23[2] - v1[3] * c23[3]; r1[3] = v1[2] * c23[3] + v1[3] * c23[2];
    v0 = r0; v1 = r1;
}

struct EpiIn {
    static constexpr bool PERM = true, MIDK = false, KSPLIT = false;
    bf16_t* proj; float* ssq_q; float* ssq_kv; bf16_t* vts; bf16_t* kr; const f32x2* cs;
    DI void operator()(AccRef acc, const Unit& u, int wr, int wc, int fr, int fq) const {
        const int row0 = u.pm * 256 + wr * 64 + fr, colt = u.pn * 256, lc0 = wc * 32 + 8 * fq;
#pragma unroll
        for (int ai = 0; ai < 2; ++ai)
#pragma unroll
            for (int m = 0; m < 4; ++m) {
                const int row = row0 + ai * 128 + m * 16;
                bf16_t* rp = proj + (size_t)row * DIN_P + colt + lc0;
#pragma unroll
                for (int bj = 0; bj < 2; ++bj) *(u32x4*)(rp + bj * 128) = pack8(acc[ai][bj][m][0], acc[ai][bj][m][1]);
            }
        if (u.pn < 6) {
            float* sq = u.pn < 4 ? ssq_q : ssq_kv;
#pragma unroll
            for (int ai = 0; ai < 2; ++ai)
#pragma unroll
                for (int m = 0; m < 4; ++m) { const float s = row_sq(acc, ai, m); if (fq == 0) unsafeAtomicAdd(sq + row0 + ai * 128 + m * 16, s); }
        }
    }
};

struct EpiKr {
    static constexpr bool PERM = true, MIDK = false, KSPLIT = true;
    float* krp;
    DI void operator()(AccRef acc, const Unit& u, int wr, int wc, int fr, int fq) const {
        if (wc >= 2) return;
        const int row0 = u.pm * 256 + wr * 64 + fr, lc0 = wc * 32 + 8 * fq;
#pragma unroll
        for (int ai = 0; ai < 2; ++ai)
#pragma unroll
            for (int m = 0; m < 4; ++m) {
                float* rp = krp + ((size_t)u.half * T + row0 + ai * 128 + m * 16) * 64 + lc0;
                *(f32x4*)rp = acc[ai][0][m][0]; *(f32x4*)(rp + 4) = acc[ai][0][m][1];
            }
    }
};

struct EpiVt {
    static constexpr bool PERM = true, MIDK = false, KSPLIT = false;
    bf16_t* out; int rows_per_batch; const float* ssq; float inv_dim;
    DI void operator()(AccRef acc, const Unit& u, int wr, int wc, int fr, int fq) const {
        const int n0 = u.pm * 256 + wr * 64 + fr, t0 = u.pn * 256 + wc * 32 + 8 * fq, b = t0 >> 13, s0 = t0 & (S - 1);
        f32x4 sc[2][2];
#pragma unroll
        for (int bj = 0; bj < 2; ++bj)
#pragma unroll
            for (int n = 0; n < 2; ++n) {
                if (ssq) { const f32x4 q = *(const f32x4*)(ssq + t0 + bj * 128 + 4 * n);
#pragma unroll
                    for (int j = 0; j < 4; ++j) sc[bj][n][j] = rsqrtf(q[j] * inv_dim + EPS);
                } else sc[bj][n] = (f32x4){1.f, 1.f, 1.f, 1.f};
            }
#pragma unroll
        for (int ai = 0; ai < 2; ++ai)
#pragma unroll
            for (int m = 0; m < 4; ++m) {
                bf16_t* rp = out + ((size_t)(b * rows_per_batch + n0 + ai * 128 + m * 16)) * VPITCH + s0;
#pragma unroll
                for (int bj = 0; bj < 2; ++bj) *(u32x4*)(rp + bj * 128) = pack8(acc[ai][bj][m][0] * sc[bj][0], acc[ai][bj][m][1] * sc[bj][1]);
            }
    }
};

template <int MODE> struct EpiUp {
    static constexpr bool PERM = true, MIDK = false, KSPLIT = false;
    const float* ssq; float inv_dim, mul; bf16_t* out; int ldc; const f32x2* cs; bf16_t* vt;
    template <bool ROPE> DI void run(AccRef acc, const Unit& u, int wr, int wc, int fr, int fq) const {
        const int row0 = u.pm * 256 + wr * 64 + fr, colt = u.pn * 256, lc0 = wc * 32 + 8 * fq;
        float sc[2][4];
#pragma unroll
        for (int ai = 0; ai < 2; ++ai)
#pragma unroll
            for (int m = 0; m < 4; ++m) sc[ai][m] = ssq[row0 + ai * 128 + m * 16];
#pragma unroll
        for (int ai = 0; ai < 2; ++ai) {
            f32x4 c01[4], c23[4];
            if (ROPE) {
#pragma unroll
                for (int m = 0; m < 4; ++m) { const f32x2* cp = cs + (size_t)(row0 + ai * 128 + m * 16) * 32 + (wc & 1) * 16 + 4 * fq; c01[m] = *(const f32x4*)cp; c23[m] = *(const f32x4*)(cp + 2); }
            }
#pragma unroll
            for (int m = 0; m < 4; ++m) {
                const int row = row0 + ai * 128 + m * 16;
                const float scl = rsqrtf(sc[ai][m] * inv_dim + EPS) * mul;
#pragma unroll
                for (int bj = 0; bj < 2; ++bj) {
                    f32x4 v0 = acc[ai][bj][m][0] * scl, v1 = acc[ai][bj][m][1] * scl;
                    if (ROPE) {
                        const f32x4 a = c01[m], bq = c23[m]; f32x4 r0, r1;
                        r0[0] = v0[0] * a[0] - v0[1] * a[1]; r0[1] = v0[0] * a[1] + v0[1] * a[0];
                        r0[2] = v0[2] * a[2] - v0[3] * a[3]; r0[3] = v0[2] * a[3] + v0[3] * a[2];
                        r1[0] = v1[0] * bq[0] - v1[1] * bq[1]; r1[1] = v1[0] * bq[1] + v1[1] * bq[0];
                        r1[2] = v1[2] * bq[2] - v1[3] * bq[3]; r1[3] = v1[2] * bq[3] + v1[3] * bq[2];
                        v0 = r0; v1 = r1;
                    }
                    if (MODE == 1) *(u32x4*)(out + (size_t)row * 3072 + (u.pn * 2 + bj) * 192 + lc0) = pack8(v0, v1);
                    else *(u32x4*)(out + (size_t)row * ldc + colt + bj * 128 + lc0) = pack8(v0, v1);
                }
            }
        }
    }
    DI void operator()(AccRef acc, const Unit& u, int wr, int wc, int fr, int fq) const {
        if (MODE == 0 && u.pn >= 8) run<true>(acc, u, wr, wc, fr, fq); else run<false>(acc, u, wr, wc, fr, fq);
    }
};

template <bool MIDK_> struct EpiBf16Ssq {
    static constexpr bool PERM = true, MIDK = MIDK_, KSPLIT = false;
    bf16_t* C; float* ssq; const float* ssqA; const float* ssqB;
    DI void mid(f32x4 (&acc)[2][2][4][2], const Unit& u, int wr, int wc, int fr, int fq) const {
        const int row0 = u.pm * 256 + wr * 64 + fr;
#pragma unroll
        for (int ai = 0; ai < 2; ++ai)
#pragma unroll
            for (int m = 0; m < 4; ++m) {
                const int row = row0 + ai * 128 + m * 16;
                const float ratio = rsqrtf(ssqA[row] * (1.0f / 2048.0f) + EPS) * sqrtf(ssqB[row] * (1.0f / 2048.0f) + EPS);
#pragma unroll
                for (int bj = 0; bj < 2; ++bj)
#pragma unroll
                    for (int n = 0; n < 2; ++n) acc[ai][bj][m][n] *= ratio;
            }
    }
    DI void operator()(AccRef acc, const Unit& u, int wr, int wc, int fr, int fq) const {
        const int row0 = u.pm * 256 + wr * 64 + fr, col0 = u.pn * 256 + wc * 32 + 8 * fq;
        float sb[2][4];
        if (MIDK) {
#pragma unroll
            for (int ai = 0; ai < 2; ++ai)
#pragma unroll
                for (int m = 0; m < 4; ++m) sb[ai][m] = ssqB[row0 + ai * 128 + m * 16];
        }
#pragma unroll
        for (int ai = 0; ai < 2; ++ai)
#pragma unroll
            for (int m = 0; m < 4; ++m) {
                const int row = row0 + ai * 128 + m * 16;
                float sc = 1.0f;
                if (MIDK) sc = rsqrtf(sb[ai][m] * (1.0f / 2048.0f) + EPS);
                bf16_t* rp = C + (size_t)row * D + col0;
#pragma unroll
                for (int bj = 0; bj < 2; ++bj) *(u32x4*)(rp + bj * 128) = pack8(acc[ai][bj][m][0] * sc, acc[ai][bj][m][1] * sc);
                const float s = row_sq(acc, ai, m) * sc * sc; if (fq == 0) unsafeAtomicAdd(ssq + row, s);
            }
    }
};

struct EpiSwiglu {
    static constexpr bool PERM = true, MIDK = false, KSPLIT = false;
    bf16_t* act;
    DI void operator()(AccRef acc, const Unit& u, int wr, int wc, int fr, int fq) const {
        const int row0 = u.pm * 256 + wr * 64 + fr, col0 = u.pn * 128 + wc * 32 + 8 * fq;
#pragma unroll
        for (int ai = 0; ai < 2; ++ai)
#pragma unroll
            for (int m = 0; m < 4; ++m) {
                const int row = row0 + ai * 128 + m * 16;
                f32x4 r[2];
#pragma unroll
                for (int n = 0; n < 2; ++n)
#pragma unroll
                    for (int j = 0; j < 4; ++j) { const float gt = acc[ai][0][m][n][j], up = acc[ai][1][m][n][j]; r[n][j] = gt * sigmoidf_(gt) * up; }
                *(u32x4*)(act + (size_t)row * DFF + col0) = pack8(r[0], r[1]);
            }
    }
};

struct EpiBf16 {
    static constexpr bool PERM = true, MIDK = false, KSPLIT = false;
    bf16_t* out; int ldc;
    DI void operator()(AccRef acc, const Unit& u, int wr, int wc, int fr, int fq) const {
        const int row0 = u.pm * 256 + wr * 64 + fr, col0 = u.pn * 256 + wc * 32 + 8 * fq;
#pragma unroll
        for (int ai = 0; ai < 2; ++ai)
#pragma unroll
            for (int m = 0; m < 4; ++m) {
                bf16_t* rp = out + (size_t)(row0 + ai * 128 + m * 16) * ldc + col0;
#pragma unroll
                for (int bj = 0; bj < 2; ++bj) *(u32x4*)(rp + bj * 128) = pack8(acc[ai][bj][m][0], acc[ai][bj][m][1]);
            }
    }
};

struct EpiPle {
    static constexpr bool PERM = true, MIDK = false, KSPLIT = false;
    float* out; const bf16_t* pp; const bf16_t* x2b;
    DI void operator()(AccRef acc, const Unit& u, int wr, int wc, int fr, int fq) const {
        const int row0 = u.pm * 256 + wr * 64 + fr, col0 = u.pn * 256 + wc * 32 + 8 * fq;
#pragma unroll
        for (int ai = 0; ai < 2; ++ai) {
            u32x4 pv[4][2], xv[4][2];
#pragma unroll
            for (int m = 0; m < 4; ++m)
#pragma unroll
                for (int bj = 0; bj < 2; ++bj) { const size_t o = (size_t)(row0 + ai * 128 + m * 16) * D + col0 + bj * 128; pv[m][bj] = *(const u32x4*)(pp + o); xv[m][bj] = *(const u32x4*)(x2b + o); }
#pragma unroll
            for (int m = 0; m < 4; ++m)
#pragma unroll
                for (int bj = 0; bj < 2; ++bj) {
                    float* op = out + (size_t)(row0 + ai * 128 + m * 16) * D + col0 + bj * 128;
                    const u32x4 p4 = pv[m][bj], x4 = xv[m][bj];
                    const f32x4 a0 = acc[ai][bj][m][0], a1 = acc[ai][bj][m][1];
                    f32x4 x0, x1;
                    x0[0] = bflo(x4.x) + sigmoidf_(a0[0]) * bflo(p4.x); x0[1] = bfhi(x4.x) + sigmoidf_(a0[1]) * bfhi(p4.x);
                    x0[2] = bflo(x4.y) + sigmoidf_(a0[2]) * bflo(p4.y); x0[3] = bfhi(x4.y) + sigmoidf_(a0[3]) * bfhi(p4.y);
                    x1[0] = bflo(x4.z) + sigmoidf_(a1[0]) * bflo(p4.z); x1[1] = bfhi(x4.z) + sigmoidf_(a1[1]) * bfhi(p4.z);
                    x1[2] = bflo(x4.w) + sigmoidf_(a1[2]) * bflo(p4.w); x1[3] = bfhi(x4.w) + sigmoidf_(a1[3]) * bfhi(p4.w);
                    *(f32x4*)op = x0; *(f32x4*)(op + 4) = x1;
                }
        }
    }
};

struct TDesc { const float* src; int N; int c0; bf16_t* dst; int ldk; int n0; int perm; const float* rowscale; float colscale; const float* rowscale_hi; };

typedef const float __attribute__((address_space(1)))* gfp_t;
typedef const f32x4 __attribute__((address_space(1)))* gf4p_t;
DI void transpose_item(const TDesc& d, int kt, LAS float* scr, int lane) {
    const int k0 = kt * 64;
    const int lr = lane >> 4, lc = (lane & 15) * 4;
    f32x4 v[16]; float rsv[16];
    const gfp_t src = (gfp_t)(d.src + (size_t)(k0 + lr) * d.N + d.c0 + lc);
#pragma unroll
    for (int i = 0; i < 16; ++i) v[i] = *(gf4p_t)(src + (size_t)(4 * i) * d.N);
    if (d.rowscale) {
        const gfp_t rsp = (gfp_t)(((d.rowscale_hi && k0 >= 2048) ? d.rowscale_hi + (k0 - 2048) : d.rowscale + k0) + lr);
#pragma unroll
        for (int i = 0; i < 16; ++i) rsv[i] = rsp[4 * i] * d.colscale;
    } else {
#pragma unroll
        for (int i = 0; i < 16; ++i) rsv[i] = d.colscale;
    }
#pragma unroll
    for (int i = 0; i < 16; ++i) {
        LAS float* sp = scr + (4 * i + lr) * 65 + lc;
        sp[0] = v[i][0] * rsv[i]; sp[1] = v[i][1] * rsv[i]; sp[2] = v[i][2] * rsv[i]; sp[3] = v[i][3] * rsv[i];
    }
    asm volatile("s_waitcnt lgkmcnt(0)" ::: "memory");
    const int c = lane & 7;
#pragma unroll
    for (int j = 0; j < 8; ++j) {
        const int n = (lane >> 3) + 8 * j;
        const int sn = d.perm ? ((n >> 1) + 32 * (n & 1)) : n;
        const LAS float* s = scr + (8 * c) * 65 + sn;
        u32x4 o; o.x = pk2(s[0], s[65]); o.y = pk2(s[130], s[195]); o.z = pk2(s[260], s[325]); o.w = pk2(s[390], s[455]);
        *(u32x4 __attribute__((address_space(1)))*)(d.dst + (size_t)(d.n0 + n) * d.ldk + k0 + 8 * c) = o;
    }
    asm volatile("s_waitcnt lgkmcnt(0)" ::: "memory");
}

struct Ptrs {
    const float *x, *p; const int* pos; const float *g_attn_pre, *w_in, *g_qa, *w_qup, *g_kva, *w_kvup, *sinks, *g_mla, *g_swa, *w_o, *g_attn_post, *g_ffn_pre,
        *w_gate, *w_up, *w_down, *g_ffn_post, *w_pg, *w_pp;
    float* out; unsigned char* ws;
};

constexpr int IT_IN = 65 * 64, IT_QUP = 48 * 16, IT_KVUP = 64 * 8, IT_O = 64 * 64, IT_GU = 344 * 64, IT_DN = 64 * 172, IT_PG = 64 * 64, IT_PP = 64 * 4;
constexpr int IT_TOTAL = IT_IN + IT_QUP + IT_KVUP + IT_O + IT_GU + IT_DN + IT_PG + IT_PP;

DI void conv_item(const Ptrs& P, int it, LAS float* scr, int lane) {
    TDesc d; int kt; d.perm = 0; d.rowscale = nullptr; d.colscale = 1.0f; d.rowscale_hi = nullptr;
    unsigned char* ws = P.ws;
    if (it < IT_IN) { const int jt = it % 65; kt = it / 65; d.src = P.w_in; d.N = 4160; d.dst = (bf16_t*)(ws + WS_WIN); d.ldk = D; d.n0 = jt * 64;
        if (jt < 24) d.c0 = 64 * jt; else if (jt < 56) { d.c0 = 1600 + 64 * (jt - 24); d.colscale = SWA_QSCALE; } else if (jt < 64) d.c0 = 3648 + 64 * (jt - 56); else { d.c0 = 1536; d.perm = 1; }
    } else if ((it -= IT_IN) < IT_QUP) { const int jt = it % 48; kt = it / 48; d.src = P.w_qup; d.N = 3072; d.dst = (bf16_t*)(ws + WS_WQUP); d.ldk = 1024; d.n0 = jt * 64; d.rowscale = P.g_qa;
        if (jt < 32) d.c0 = (jt >> 1) * 192 + 64 * (jt & 1); else { d.c0 = (jt - 32) * 192 + 128; d.perm = 1; }
    } else if ((it -= IT_QUP) < IT_KVUP) { const int jt = it % 64; kt = it / 64; d.src = P.w_kvup; d.N = 4096; d.dst = (bf16_t*)(ws + WS_WKVUP); d.ldk = 512; d.n0 = jt * 64; d.rowscale = P.g_kva;
        if (jt < 32) d.c0 = (jt >> 1) * 256 + 64 * (jt & 1); else d.c0 = ((jt - 32) >> 1) * 256 + 128 + 64 * (jt & 1);
    } else if ((it -= IT_KVUP) < IT_O) { const int jt = it % 64; kt = it / 64; d.src = P.w_o; d.N = D; d.dst = (bf16_t*)(ws + WS_WO); d.ldk = D; d.n0 = jt * 64; d.c0 = jt * 64; d.rowscale = P.g_mla; d.rowscale_hi = P.g_swa;
    } else if ((it -= IT_O) < IT_GU) { const int jt = it % 344; kt = it / 344; const int t = jt >> 2, sub = jt & 3; d.src = sub < 2 ? P.w_gate : P.w_up; d.N = DFF; d.dst = (bf16_t*)(ws + WS_WGU); d.ldk = D; d.n0 = jt * 64;
        d.c0 = 128 * t + 64 * (sub & 1);
    } else if ((it -= IT_GU) < IT_DN) { const int jt = it % 64; kt = it / 64; d.src = P.w_down; d.N = D; d.dst = (bf16_t*)(ws + WS_WDN); d.ldk = DFF; d.n0 = jt * 64; d.c0 = jt * 64;
    } else if ((it -= IT_DN) < IT_PG) { const int jt = it % 64; kt = it / 64; d.src = P.w_pg; d.N = D; d.dst = (bf16_t*)(ws + WS_WPG); d.ldk = D; d.n0 = jt * 64; d.c0 = jt * 64;
    } else { it -= IT_PG; const int jt = it % 64; kt = it / 64; d.src = P.w_pp; d.N = D; d.dst = (bf16_t*)(ws + WS_WPP); d.ldk = PLE; d.n0 = jt * 64; d.c0 = jt * 64; }
    transpose_item(d, kt, scr, lane);
}

DI void sincos_d(double a, float& c, float& s) {
    const double n = __builtin_rint(a * 0.15915494309189535);
    double r = __builtin_fma(-n, 6.283185307179586, a);
    r = __builtin_fma(-n, 2.4492935982947064e-16, r);
    double sg = 1.0;
    if (r > 1.5707963267948966) { r = 3.141592653589793 - r; sg = -1.0; }
    else if (r < -1.5707963267948966) { r = -3.141592653589793 - r; sg = -1.0; }
    const double r2 = r * r;
    double ps = -1.0 / 1307674368000.0;
    ps = ps * r2 + 1.0 / 6227020800.0; ps = ps * r2 - 1.0 / 39916800.0; ps = ps * r2 + 1.0 / 362880.0; ps = ps * r2 - 1.0 / 5040.0;
    ps = ps * r2 + 1.0 / 120.0; ps = ps * r2 - 1.0 / 6.0; ps = ps * r2 + 1.0;
    double pc = 1.0 / 20922789888000.0;
    pc = pc * r2 - 1.0 / 87178291200.0; pc = pc * r2 + 1.0 / 479001600.0; pc = pc * r2 - 1.0 / 3628800.0; pc = pc * r2 + 1.0 / 40320.0;
    pc = pc * r2 - 1.0 / 720.0; pc = pc * r2 + 1.0 / 24.0; pc = pc * r2 - 0.5; pc = pc * r2 + 1.0;
    s = (float)(ps * r); c = (float)(sg * pc);
}

DI void phase0(const Ptrs& P, LAS unsigned char* lds) {
    const int tid = my_tid(), lane = tid & 63, wave = tid >> 6;
    const int gw = blockIdx.x * 8 + wave, NGW = gridDim.x * 8;
    const int gt = blockIdx.x * 512 + tid, NGT = gridDim.x * 512;
    unsigned char* ws = P.ws;
    { float* sq = (float*)(ws + WS_SSQ); for (int i = gt; i < 6 * T; i += NGT) sq[i] = 0.f; }
    { f32x2* cs = (f32x2*)(ws + WS_CS);
      for (int i = gt; i < T * 32; i += NGT) { const int t = i >> 5, f = i & 31; double fr = 1.0; for (int k = 0; k < f; ++k) fr *= 0.7498942093324559;
          float c, s; sincos_d((double)P.pos[t] * fr, c, s); cs[i] = (f32x2){c, s}; } }
    { bf16_t* pb = (bf16_t*)(ws + WS_PB);
      for (int i = gt; i < T * PLE / 8; i += NGT) { const f32x4 a = *(const f32x4*)(P.p + (size_t)i * 8), b = *(const f32x4*)(P.p + (size_t)i * 8 + 4); *(u32x4*)(pb + (size_t)i * 8) = pack8(a, b); } }
    { bf16_t* h = (bf16_t*)(ws + WS_R0);
      for (int row = gw; row < T; row += NGW) {
          const f32x4* xr = (const f32x4*)(P.x + (size_t)row * D) + lane;
          f32x4 v[16]; float s = 0.f;
#pragma unroll
          for (int j = 0; j < 16; ++j) { v[j] = xr[64 * j]; s += (v[j][0] * v[j][0] + v[j][1] * v[j][1]) + (v[j][2] * v[j][2] + v[j][3] * v[j][3]); }
          const float rs = rsqrtf(wave_sum(s) * (1.0f / D) + EPS);
          u32x2* o = (u32x2*)(h + (size_t)row * D) + lane;
          const f32x4* gr = (const f32x4*)P.g_attn_pre + lane;
          f32x4 gv[16];
#pragma unroll
          for (int j = 0; j < 16; ++j) gv[j] = gr[64 * j];
#pragma unroll
          for (int j = 0; j < 16; ++j) { const f32x4 g = gv[j]; u32x2 w; w.x = pk2(v[j][0] * rs * g[0], v[j][1] * rs * g[1]); w.y = pk2(v[j][2] * rs * g[2], v[j][3] * rs * g[3]); o[64 * j] = w; }
      } }
    { LAS float* scr = (LAS float*)(lds + wave * 16640);
      for (int it = gw; it < IT_TOTAL; it += NGW) conv_item(P, it, scr, lane); }
}

DI void kr_phase(const Ptrs& P) {
    unsigned char* ws = P.ws; const float* krp = (const float*)(ws + WS_KRP); const f32x2* cs = (const f32x2*)(ws + WS_CS); bf16_t* k192 = (bf16_t*)(ws + WS_KN);
    const int tid = my_tid(), gt = blockIdx.x * 512 + tid, NGT = gridDim.x * 512;
    for (int idx = gt; idx < T * 8; idx += NGT) {
        const int row = idx >> 3, c0 = (idx & 7) * 8;
        f32x4 v0 = {0.f, 0.f, 0.f, 0.f}, v1 = {0.f, 0.f, 0.f, 0.f};
#pragma unroll
        for (int kq = 0; kq < 4; ++kq) { const float* p = krp + ((size_t)kq * T + row) * 64 + c0; v0 += *(const f32x4*)p; v1 += *(const f32x4*)(p + 4); }
        rope8(v0, v1, cs + (size_t)row * 32 + (c0 >> 1));
        const u32x4 pv = pack8(v0, v1);
        bf16_t* kp = k192 + (size_t)row * 3072 + 128 + c0;
#pragma unroll
        for (int hd = 0; hd < 16; ++hd) *(u32x4*)(kp + hd * 192) = pv;
    }
}

#define MFMA32(a, b, c) __builtin_amdgcn_mfma_f32_32x32x16_bf16((a), (b), (c), 0, 0, 0)
DI bf16x8 packp(const f32x16& x, int s) {
    u32x4 p; p.x = pk2(x[8 * s], x[8 * s + 1]); p.y = pk2(x[8 * s + 2], x[8 * s + 3]); p.z = pk2(x[8 * s + 4], x[8 * s + 5]); p.w = pk2(x[8 * s + 6], x[8 * s + 7]);
    return __builtin_bit_cast(bf16x8, p);
}
DI f32x16 zero16() { f32x16 z;
#pragma unroll
    for (int i = 0; i < 16; ++i) z[i] = 0.f;
    return z; }

DI void mla_phase(const Ptrs& P, LAS unsigned char* lds, float* ssqbase) {
    unsigned char* ws = P.ws;
    const bf16_t* q = (const bf16_t*)(ws + WS_Q); const unsigned char* k192 = ws + WS_KN;
    const unsigned char* vt = ws + WS_VT; bf16_t* mixed = (bf16_t*)(ws + WS_R0); float* ssqA = ssqbase + 2 * T;
    const int tid = my_tid(), lane = tid & 63, w = __builtin_amdgcn_readfirstlane(tid >> 6), qi = lane & 31, g = lane >> 5;
    constexpr int KBYTES = 64 * 384, BUF = KBYTES + 128 * 128;
    const float NINF = -__builtin_inff();
    unsigned koff[3], voff[2];
#pragma unroll
    for (int i = 0; i < 3; ++i) { const int u = 64 * (w * 3 + i) + lane, row = u / 24, pos = u % 24, ch = (pos & ~7) | ((pos & 7) ^ ((row >> 1) & 7)); koff[i] = (unsigned)(row * 6144 + ch * 16); }
#pragma unroll
    for (int i = 0; i < 2; ++i) { const int u = 64 * (w * 2 + i) + lane, d = u >> 3, pos = u & 7, ch = pos ^ ((d >> 1) & 7); voff[i] = (unsigned)(d * (VPITCH * 2) + ch * 16); }
    int kaddr[4], vaddr[4];
    { const int pr = pi32(qi), swk = (pr >> 1) & 7, swv = (qi >> 1) & 7;
#pragma unroll
      for (int j = 0; j < 4; ++j) { kaddr[j] = pr * 384 + 16 * ((2 * j + g) ^ swk); vaddr[j] = KBYTES + qi * 128 + 16 * ((2 * j + g) ^ swv); } }
    const unsigned ldsbase = (unsigned)(size_t)lds;
#define MLA_DMA(kt, bufoff) do { const unsigned char* _kb = uni_ptr(kbase + (size_t)(kt) * (64 * 6144)); const unsigned char* _vb = uni_ptr(vbase + (size_t)(kt) * 128); const unsigned _l = ldsbase + (unsigned)(bufoff); \
        _Pragma("unroll") for (int _i = 0; _i < 3; ++_i) dma16(_kb, koff[_i], _l + (unsigned)((w * 3 + _i) * 1024)); \
        _Pragma("unroll") for (int _i = 0; _i < 2; ++_i) dma16(_vb, voff[_i], _l + (unsigned)(KBYTES + (w * 2 + _i) * 1024)); } while (0)
    for (int uu0 = blockIdx.x; uu0 < 1024 * (PROBE_PH == 31 ? PROBE_N : 1); uu0 += gridDim.x) {
        const int uu = uu0 & 1023;
        const int kk = uu >> 8, c = uu & 255, bh = c & 31, jj = c >> 5;
        const int qb = kk == 0 ? 31 - jj : kk == 1 ? 16 + jj : kk == 2 ? 15 - jj : jj;
        const int b = bh >> 4, h = bh & 15;
        const int r0 = qb * 256 + w * 32;
        const unsigned char* kbase = k192 + ((size_t)(b * S) * 16 + h) * 384;
        const unsigned char* vbase = vt + (size_t)(bh * 128) * (VPITCH * 2);
        const int nkt = 4 * (qb + 1);
        MLA_DMA(0, 0); MLA_DMA(1, BUF);
        bf16x8 qf[12];
        { const bf16_t* qrow = q + (size_t)(b * S + r0 + qi) * QW;
#pragma unroll
          for (int ks = 0; ks < 8; ++ks) qf[ks] = *(const bf16x8*)(qrow + h * 128 + ks * 16 + g * 8);
#pragma unroll
          for (int ks = 0; ks < 4; ++ks) qf[8 + ks] = *(const bf16x8*)(qrow + 2048 + h * 64 + ks * 16 + g * 8); }
        f32x16 oacc[4];
#pragma unroll
        for (int i = 0; i < 4; ++i) oacc[i] = zero16();
        float m_run = NINF, l_run = 0.f;
#pragma unroll
        for (int ks = 0; ks < 12; ++ks) asm volatile("" :: "v"(qf[ks]));
        asm volatile("s_waitcnt vmcnt(0)" ::: "memory"); __syncthreads();
#define MLA_QK(KA, IMM, sacc_) do { \
        bf16x8 fa[4], fb[4]; \
        _Pragma("unroll") for (int j = 0; j < 4; ++j) fa[j] = *(const LAS bf16x8*)(lds + KA[j] + (IMM)); \
        _Pragma("unroll") for (int j = 0; j < 4; ++j) fb[j] = *(const LAS bf16x8*)(lds + KA[j] + (IMM) + 128); \
        __builtin_amdgcn_sched_barrier(0); \
        __builtin_amdgcn_s_setprio(1); \
        _Pragma("unroll") for (int gi = 0; gi < 6; gi += 2) { \
            _Pragma("unroll") for (int j = 0; j < 4; ++j) sacc_[gi / 3] = MFMA32(fa[j], qf[4 * (gi % 3) + j], sacc_[gi / 3]); \
            if (gi + 2 < 6) { _Pragma("unroll") for (int j = 0; j < 4; ++j) fa[j] = *(const LAS bf16x8*)(lds + KA[j] + (IMM) + 128 * ((gi + 2) % 3) + 12288 * ((gi + 2) / 3)); } \
            __builtin_amdgcn_sched_barrier(0); \
            _Pragma("unroll") for (int j = 0; j < 4; ++j) sacc_[(gi + 1) / 3] = MFMA32(fb[j], qf[4 * ((gi + 1) % 3) + j], sacc_[(gi + 1) / 3]); \
            if (gi + 3 < 6) { _Pragma("unroll") for (int j = 0; j < 4; ++j) fb[j] = *(const LAS bf16x8*)(lds + KA[j] + (IMM) + 128 * ((gi + 3) % 3) + 12288 * ((gi + 3) / 3)); } \
            __builtin_amdgcn_sched_barrier(0); \
        } \
        __builtin_amdgcn_s_setprio(0); } while (0)
#define MLA_SMPV(VA, IMM, sacc_, kt_) do { \
        if (64 * (kt_) + 63 > r0) { \
            const int qrow = r0 + qi; \
            _Pragma("unroll") for (int kb = 0; kb < 2; ++kb) \
            _Pragma("unroll") for (int e = 0; e < 16; ++e) { const int key = 64 * (kt_) + kb * 32 + 16 * (e >> 3) + 8 * g + (e & 7); if (key > qrow) sacc_[kb][e] = NINF; } \
        } \
        float mx = NINF; \
        _Pragma("unroll") for (int kb = 0; kb < 2; ++kb) \
        _Pragma("unroll") for (int e = 0; e < 16; ++e) mx = fmaxf(mx, sacc_[kb][e]); \
        mx = xhalf_max(mx); \
        const float m_new = fmaxf(m_run, mx); \
        const float alpha = fast_exp2(m_run - m_new); \
        const bool resc = m_new != m_run; \
        m_run = m_new; \
        float lsum = 0.f; \
        _Pragma("unroll") for (int kb = 0; kb < 2; ++kb) \
        _Pragma("unroll") for (int e = 0; e < 16; ++e) { const float p = fast_exp2(sacc_[kb][e] - m_new); sacc_[kb][e] = p; lsum += p; } \
        l_run = l_run * alpha + lsum; \
        if (__builtin_amdgcn_ballot_w64(resc) != 0ull) { \
            _Pragma("unroll") for (int db = 0; db < 4; ++db) \
            _Pragma("unroll") for (int e = 0; e < 16; ++e) oacc[db][e] *= alpha; \
        } \
        _Pragma("unroll") for (int kb = 0; kb < 2; ++kb) \
        _Pragma("unroll") for (int s2 = 0; s2 < 2; ++s2) { \
            const bf16x8 pf = packp(sacc_[kb], s2); \
            _Pragma("unroll") for (int db = 0; db < 4; ++db) oacc[db] = MFMA32(*(const LAS bf16x8*)(lds + VA[kb * 2 + s2] + (IMM) + 4096 * db), pf, oacc[db]); \
        } } while (0)
#define MLA_INTERVAL(KA, VA, kp_, NB) do { \
        { f32x16 sacc[2]; sacc[0] = zero16(); sacc[1] = zero16(); \
          if (64 * (kp_) <= r0) { MLA_QK(KA, 0, sacc); MLA_SMPV(VA, 0, sacc, (kp_)); } } \
        if ((kp_) + 2 < nkt) { MLA_DMA((kp_) + 2, (NB)); MLA_DMA((kp_) + 3, (NB) + BUF); } \
        { f32x16 sacc[2]; sacc[0] = zero16(); sacc[1] = zero16(); \
          if (64 * ((kp_) + 1) <= r0) { MLA_QK(KA, BUF, sacc); MLA_SMPV(VA, BUF, sacc, (kp_) + 1); } } \
        asm volatile("s_waitcnt vmcnt(0)" ::: "memory"); __syncthreads(); } while (0)
        int kaddrH[4], vaddrH[4];
#pragma unroll
        for (int j = 0; j < 4; ++j) { kaddrH[j] = kaddr[j] + 2 * BUF; vaddrH[j] = vaddr[j] + 2 * BUF; }
#pragma unroll 1
        for (int kp = 0; kp < nkt; kp += 4) {
            MLA_INTERVAL(kaddr, vaddr, kp, 2 * BUF);
            MLA_INTERVAL(kaddrH, vaddrH, kp + 2, 0);
        }
#undef MLA_QK
#undef MLA_SMPV
#undef MLA_INTERVAL
        const float l = l_run + __shfl_xor(l_run, 32);
        const float inv = 1.0f / l;
        float sq = 0.f;
        bf16_t* orow = mixed + (size_t)(b * S + r0 + qi) * D + h * 128 + 8 * g;
#pragma unroll
        for (int db = 0; db < 4; ++db)
#pragma unroll
            for (int t2 = 0; t2 < 2; ++t2) {
                unsigned wa[2], wb[2];
#pragma unroll
                for (int q2 = 0; q2 < 2; ++q2) {
                    const int j4 = 2 * t2 + q2;
                    const float o0 = oacc[db][4 * j4] * inv, o1 = oacc[db][4 * j4 + 1] * inv, o2 = oacc[db][4 * j4 + 2] * inv, o3 = oacc[db][4 * j4 + 3] * inv;
                    sq += (o0 * o0 + o1 * o1) + (o2 * o2 + o3 * o3);
                    if (q2 == 0) { wa[0] = pk2(o0, o1); wa[1] = pk2(o2, o3); } else { wb[0] = pk2(o0, o1); wb[1] = pk2(o2, o3); }
                }
                const auto rx = __builtin_amdgcn_permlane32_swap(wa[0], wb[0], false, false);
                const auto ry = __builtin_amdgcn_permlane32_swap(wa[1], wb[1], false, false);
                u32x4 wv; wv.x = rx[0]; wv.y = ry[0]; wv.z = rx[1]; wv.w = ry[1];
                *(u32x4*)(orow + 32 * db + 16 * t2) = wv;
            }
        sq += __shfl_xor(sq, 32);
        if (g == 0) unsafeAtomicAdd(ssqA + (uu0 >= 1024 ? 6 * T : 0) + b * S + r0 + qi, sq);
    }
#undef MLA_DMA
}

DI void swa_phase(const Ptrs& P, LAS unsigned char* lds, float* ssqbase) {
    unsigned char* ws = P.ws;
    const bf16_t* proj = (const bf16_t*)(ws + WS_PROJ); const bf16_t* vts = (const bf16_t*)(ws + WS_VTS);
    bf16_t* mixed = (bf16_t*)(ws + WS_R0); float* ssqB = ssqbase + 3 * T;
    const int tid = my_tid(), lane = tid & 63, w = __builtin_amdgcn_readfirstlane(tid >> 6), qi = lane & 31, g = lane >> 5;
    constexpr int KST = 144, VST = 528, KBYTES = 256 * KST, VBYTES = 64 * VST;
    LAS float* POS = (LAS float*)(lds + KBYTES + VBYTES);
    const float NINF = -__builtin_inff();
    for (int uu0 = blockIdx.x; uu0 < 2048 * (PROBE_PH == 32 ? PROBE_N : 1); uu0 += gridDim.x) {
        const int uu = uu0 & 2047;
        const int hp = uu & 3, gk = (uu >> 2) & 3, n = (uu >> 4) & 63, b = uu >> 10;
        const int key_base = (n - 1) * 128;
        __syncthreads();
#pragma unroll
        for (int i = 0; i < 4; ++i) {
            const int id = tid + 512 * i;
            { const int kl = id >> 3, ch = id & 7, key = key_base + kl, keyc = key < 0 ? 0 : key;
              u32x4 v = *(const u32x4*)(proj + (size_t)(b * S + keyc) * DIN_P + PJ_KS + gk * 64 + ch * 8);
              if (key < 0) v = (u32x4){0u, 0u, 0u, 0u};
              *(LAS u32x4*)(lds + kl * KST + ch * 16) = v; }
            { const int d = id >> 5, ch = id & 31, key = key_base + ch * 8, keyc = key < 0 ? 0 : key;
              u32x4 v = *(const u32x4*)(vts + (size_t)((b * 4 + gk) * 64 + d) * VPITCH + keyc);
              if (key < 0) v = (u32x4){0u, 0u, 0u, 0u};
              *(LAS u32x4*)(lds + KBYTES + d * VST + ch * 16) = v; }
        }
        if (tid < 256) { const int key = key_base + tid, keyc = key < 0 ? 0 : key; const float pv = (float)P.pos[b * S + keyc]; POS[tid] = key >= 0 ? pv : 0.f; }
        __syncthreads();
        const int head = gk * 8 + hp * 2 + (w >> 2), wq = w & 3, qoff = wq * 32;
        const int trow = b * S + n * 128 + qoff + qi;
        bf16x8 qf[4];
#pragma unroll
        for (int ks = 0; ks < 4; ++ks) qf[ks] = *(const bf16x8*)(proj + (size_t)trow * DIN_P + PJ_QS + head * 64 + ks * 16 + g * 8);
        const float posq = (float)P.pos[trow];
        const float slope2 = fast_exp2(-0.25f * (float)(head + 1)) * LOG2E;
        const float sink2 = P.sinks[head] * LOG2E;
        f32x16 sacc[5];
#pragma unroll
        for (int t = 0; t < 5; ++t) {
            const int kb = wq + t;
            const LAS unsigned char* kp = lds + (kb * 32 + pi32(qi)) * KST + g * 16;
            f32x16 a = zero16();
#pragma unroll
            for (int ks = 0; ks < 4; ++ks) a = MFMA32(*(const LAS bf16x8*)(kp + ks * 32), qf[ks], a);
            sacc[t] = a;
            __builtin_amdgcn_sched_barrier(0);
        }
        float mx = sink2;
#pragma unroll
        for (int t = 0; t < 5; ++t) {
            const int kb = wq + t;
            const bool padblk = (n == 0) && (kb < 4);
#pragma unroll
            for (int hh = 0; hh < 2; ++hh) {
                const int kl0 = kb * 32 + 16 * hh + 8 * g;
                const f32x4 pa = *(const LAS f32x4*)(POS + kl0), pb = *(const LAS f32x4*)(POS + kl0 + 4);
#pragma unroll
                for (int e = 0; e < 8; ++e) {
                    const int kll = 16 * hh + 8 * g + e;
                    const float pk = e < 4 ? pa[e & 3] : pb[e & 3];
                    float sv = sacc[t][8 * hh + e] - slope2 * fabsf(posq - pk);
                    bool valid = !padblk;
                    if (t == 0) valid = valid && (kll > qi);
                    if (t == 4) valid = valid && (kll <= qi);
                    sv = valid ? sv : NINF;
                    sacc[t][8 * hh + e] = sv; mx = fmaxf(mx, sv);
                }
            }
        }
        mx = xhalf_max(mx);
        float lsum = 0.f;
#pragma unroll
        for (int t = 0; t < 5; ++t)
#pragma unroll
            for (int e = 0; e < 16; ++e) { const float p = fast_exp2(sacc[t][e] - mx); sacc[t][e] = p; lsum += p; }
        f32x16 oacc[2]; oacc[0] = zero16(); oacc[1] = zero16();
#pragma unroll
        for (int t = 0; t < 5; ++t) {
            const int kb = wq + t;
#pragma unroll
            for (int s2 = 0; s2 < 2; ++s2) {
                const bf16x8 pf = packp(sacc[t], s2);
#pragma unroll
                for (int db = 0; db < 2; ++db) {
                    const LAS unsigned char* vp = lds + KBYTES + (32 * db + qi) * VST + (kb * 32 + 16 * s2 + 8 * g) * 2;
                    oacc[db] = MFMA32(*(const LAS bf16x8*)vp, pf, oacc[db]);
                }
                __builtin_amdgcn_sched_barrier(0);
            }
        }
        const float l = lsum + __shfl_xor(lsum, 32) + fast_exp2(sink2 - mx);
        const float inv = 1.0f / l;
        float sq = 0.f;
        bf16_t* orow = mixed + (size_t)trow * D + 2048 + head * 64 + 4 * g;
#pragma unroll
        for (int db = 0; db < 2; ++db)
#pragma unroll
            for (int j4 = 0; j4 < 4; ++j4) {
                const float o0 = oacc[db][4 * j4] * inv, o1 = oacc[db][4 * j4 + 1] * inv, o2 = oacc[db][4 * j4 + 2] * inv, o3 = oacc[db][4 * j4 + 3] * inv;
                sq += (o0 * o0 + o1 * o1) + (o2 * o2 + o3 * o3);
                u32x2 wv; wv.x = pk2(o0, o1); wv.y = pk2(o2, o3);
                *(u32x2*)(orow + 32 * db + 8 * j4) = wv;
            }
        sq += __shfl_xor(sq, 32);
        if (g == 0) unsafeAtomicAdd(ssqB + (uu0 >= 2048 ? 6 * T : 0) + trow, sq);
    }
}

DI void norm_mixed_phase(const Ptrs& P) {
    unsigned char* ws = P.ws; bf16_t* mixed = (bf16_t*)(ws + WS_R0);
    const float* ssqA = (const float*)(ws + WS_SSQ) + 2 * T; const float* ssqB = ssqA + T;
    const int tid = my_tid(), lane = tid & 63, gw = blockIdx.x * 8 + (tid >> 6), NGW = gridDim.x * 8;
    for (int row = gw; row < T; row += NGW) {
        const float rsA = rsqrtf(ssqA[row] * (1.0f / 2048.0f) + EPS), rsB = rsqrtf(ssqB[row] * (1.0f / 2048.0f) + EPS);
        u32x4* mp = (u32x4*)(mixed + (size_t)row * D) + lane;
#pragma unroll
        for (int j = 0; j < 8; ++j) {
            const int col0 = (lane + 64 * j) * 8; const bool hb = col0 >= 2048;
            const float rs = hb ? rsB : rsA; const float* gp = hb ? P.g_swa + (col0 - 2048) : P.g_mla + col0;
            const f32x4 g0 = *(const f32x4*)gp, g1 = *(const f32x4*)(gp + 4);
            const u32x4 v = mp[64 * j]; u32x4 o;
            o.x = pk2(bflo(v.x) * rs * g0[0], bfhi(v.x) * rs * g0[1]); o.y = pk2(bflo(v.y) * rs * g0[2], bfhi(v.y) * rs * g0[3]);
            o.z = pk2(bflo(v.z) * rs * g1[0], bfhi(v.z) * rs * g1[1]); o.w = pk2(bflo(v.w) * rs * g1[2], bfhi(v.w) * rs * g1[3]);
            mp[64 * j] = o;
        }
    }
}
DI void x1_phase(const Ptrs& P) {
    unsigned char* ws = P.ws; const bf16_t* y = (const bf16_t*)(ws + WS_Y); const float* ssq_y = (const float*)(ws + WS_SSQ) + 4 * T; bf16_t* h2 = (bf16_t*)(ws + WS_R0);
    const int tid = my_tid(), lane = tid & 63, gw = blockIdx.x * 8 + (tid >> 6), NGW = gridDim.x * 8;
    for (int row = gw; row < T; row += NGW) {
        const float rsy = rsqrtf(ssq_y[row] * (1.0f / D) + EPS);
        const f32x4* xr = (const f32x4*)(P.x + (size_t)row * D) + lane; const u32x2* yr = (const u32x2*)(y + (size_t)row * D) + lane;
        const f32x4* gp = (const f32x4*)P.g_attn_post + lane; u32x2* op = (u32x2*)((bf16_t*)P.out + (size_t)row * D) + lane;
        f32x4 v[16]; float s = 0.f;
#pragma unroll
        for (int hb = 0; hb < 2; ++hb) {
            f32x4 a[8], gg[8]; u32x2 yb[8];
#pragma unroll
            for (int j = 0; j < 8; ++j) { a[j] = xr[64 * (8 * hb + j)]; gg[j] = gp[64 * (8 * hb + j)]; yb[j] = yr[64 * (8 * hb + j)]; }
#pragma unroll
            for (int j = 0; j < 8; ++j) { const f32x4 bq = {bflo(yb[j].x), bfhi(yb[j].x), bflo(yb[j].y), bfhi(yb[j].y)};
                const f32x4 r = a[j] + bq * rsy * gg[j]; v[8 * hb + j] = r; u32x2 xb; xb.x = pk2(r[0], r[1]); xb.y = pk2(r[2], r[3]); op[64 * (8 * hb + j)] = xb;
                s += (r[0] * r[0] + r[1] * r[1]) + (r[2] * r[2] + r[3] * r[3]); }
        }
        const f32x4* g2 = (const f32x4*)P.g_ffn_pre + lane;
        f32x4 g2v[16];
#pragma unroll
        for (int j = 0; j < 16; ++j) g2v[j] = g2[64 * j];
        const float rs = rsqrtf(wave_sum(s) * (1.0f / D) + EPS);
        u32x2* o = (u32x2*)(h2 + (size_t)row * D) + lane;
#pragma unroll
        for (int j = 0; j < 16; ++j) { const f32x4 gg = g2v[j]; u32x2 wv; wv.x = pk2(v[j][0] * rs * gg[0], v[j][1] * rs * gg[1]); wv.y = pk2(v[j][2] * rs * gg[2], v[j][3] * rs * gg[3]); o[64 * j] = wv; }
    }
}
DI void x2_phase(const Ptrs& P) {
    unsigned char* ws = P.ws; const bf16_t* f = (const bf16_t*)(ws + WS_F); const float* ssq_f = (const float*)(ws + WS_SSQ) + 5 * T; bf16_t* x2b = (bf16_t*)(ws + WS_X2B);
    const int tid = my_tid(), lane = tid & 63, gw = blockIdx.x * 8 + (tid >> 6), NGW = gridDim.x * 8;
    for (int row = gw; row < T; row += NGW) {
        const float rsf = rsqrtf(ssq_f[row] * (1.0f / D) + EPS);
        const u32x2* fr = (const u32x2*)(f + (size_t)row * D) + lane; const f32x4* gp = (const f32x4*)P.g_ffn_post + lane;
        const u32x2* op = (const u32x2*)((const bf16_t*)P.out + (size_t)row * D) + lane; u32x2* o = (u32x2*)(x2b + (size_t)row * D) + lane;
        u32x2 abv[16], fbv[16]; f32x4 ggv[16];
#pragma unroll
        for (int j = 0; j < 16; ++j) { abv[j] = op[64 * j]; fbv[j] = fr[64 * j]; ggv[j] = gp[64 * j]; }
#pragma unroll
        for (int j = 0; j < 16; ++j) { const u32x2 ab = abv[j]; const f32x4 a = {bflo(ab.x), bfhi(ab.x), bflo(ab.y), bfhi(ab.y)}, gg = ggv[j]; const u32x2 fb = fbv[j]; const f32x4 bq = {bflo(fb.x), bfhi(fb.x), bflo(fb.y), bfhi(fb.y)};
            const f32x4 r = a + bq * rsf * gg;
            u32x2 wv; wv.x = pk2(r[0], r[1]); wv.y = pk2(r[2], r[3]); o[64 * j] = wv; }
    }
}

constexpr int NPHASE = 11;
struct Params { const void* in[21]; float* out; unsigned char* ws; int ph_lo, ph_hi; };

__global__ void __launch_bounds__(512, 2) mk_fwd(Params prm) {
    extern __shared__ __attribute__((aligned(16))) unsigned char lds_raw[];
    LAS unsigned char* lds = (LAS unsigned char*)lds_raw;
#define GPTR(T, i) ((T*)(T __attribute__((address_space(1)))*)kin[i])
#define LOADP() Ptrs P; { const void* kin[23]; _Pragma("unroll") for (int _q = 0; _q < 21; ++_q) kin[_q] = prm.in[_q]; kin[21] = prm.out; kin[22] = prm.ws; \
    P.x = GPTR(const float, 0); P.p = GPTR(const float, 1); P.pos = GPTR(const int, 2); P.g_attn_pre = GPTR(const float, 3); P.w_in = GPTR(const float, 4); \
    P.g_qa = GPTR(const float, 5); P.w_qup = GPTR(const float, 6); P.g_kva = GPTR(const float, 7); P.w_kvup = GPTR(const float, 8); P.sinks = GPTR(const float, 9); \
    P.g_mla = GPTR(const float, 10); P.g_swa = GPTR(const float, 11); P.w_o = GPTR(const float, 12); P.g_attn_post = GPTR(const float, 13); P.g_ffn_pre = GPTR(const float, 14); \
    P.w_gate = GPTR(const float, 15); P.w_up = GPTR(const float, 16); P.w_down = GPTR(const float, 17); P.g_ffn_post = GPTR(const float, 18); \
    P.w_pg = GPTR(const float, 19); P.w_pp = GPTR(const float, 20); P.out = GPTR(float, 21); P.ws = GPTR(unsigned char, 22); \
 } \
    unsigned char* ws = P.ws; float* ssq = (float*)(ws + WS_SSQ); const f32x2* cs = (const f32x2*)(ws + WS_CS); (void)ssq; (void)cs;
    const int lo = prm.ph_lo, hi = prm.ph_hi;
    const int G = gridDim.x, cid = blockIdx.x;
    if (hi - lo > 1) xcd_barrier_post((unsigned*)(prm.ws + WS_KR));
    if (hi > 1000) cg::this_grid().sync();
#define IN(k) (lo <= (k) && (k) < hi)
#define SEAM(k) do { if (IN((k) + 1)) xcd_barrier((unsigned*)(ws + WS_KR)); } while (0)
#define NREP(k) ((PROBE_PH == (k) || (PROBE_PH >= 10 && PROBE_PH / 10 == (k))) ? PROBE_N : 1)
#define REPSYNC(k) do { if (_r + 1 < NREP(k)) cg::this_grid().sync(); } while (0)
    if (IN(0)) { LOADP(); phase0(P, lds); if (PROBE_PH == 0) { cg::this_grid().sync(); phase0(P, lds); } SEAM(0); }
    if (IN(1)) { LOADP();
        for (int _r = 0; _r < NREP(1); ++_r) {
        float* sq = ssq + (_r ? 6 * T : 0);
        { pg8::Gemm g{(const bf16_t*)(ws + WS_R0), (const bf16_t*)(ws + WS_WIN), T, 3840, D, D, D}; pg8::StaticOrder So; So.init(T, 3840, G, cid);
          EpiIn E{(bf16_t*)(ws + WS_PROJ), sq, sq + T, (bf16_t*)(ws + WS_VTS), (bf16_t*)(ws + WS_KN), cs};
          pg8::gemm_phase<EpiIn>(lds, g, So, E); }
        {
            const int t0 = (64 * 15) % G, gp = t0 ? G - t0 : G, cp = t0 ? cid - t0 : cid;
            if (cp >= 0) {
                pg8::Gemm g{(const bf16_t*)(ws + WS_WIN) + (size_t)3840 * D, (const bf16_t*)(ws + WS_R0), 256, T, D, D, D}; pg8::StaticOrder So; So.init(256, T, gp, cp);
                EpiVt E{(bf16_t*)(ws + WS_VTS), 256, nullptr, 0.f};
                pg8::gemm_phase<EpiVt>(lds, g, So, E);
            }
        }
        { pg8::Gemm g{(const bf16_t*)(ws + WS_R0), (const bf16_t*)(ws + WS_WIN) + (size_t)4096 * D, T, 256, 1024, D, D}; pg8::StaticOrder So; So.init(T, 256, G, cid, 2);
          EpiKr E{(float*)(ws + WS_KRP)};
          pg8::gemm_phase<EpiKr>(lds, g, So, E); }
        REPSYNC(1); }
        SEAM(1);
    }
    if (IN(2)) { LOADP();
        kr_phase(P);
        for (int _r = 0; _r < NREP(2); ++_r) {
        { pg8::Gemm g{(const bf16_t*)(ws + WS_PROJ) + PJ_CQ, (const bf16_t*)(ws + WS_WQUP), T, QW, 1024, DIN_P, 1024}; pg8::StaticOrder So; So.init(T, QW, G, cid);
          EpiUp<0> E{ssq, 1.0f / 1024.0f, MLA_QSCALE, (bf16_t*)(ws + WS_Q), QW, cs, nullptr};
          pg8::gemm_phase<EpiUp<0>>(lds, g, So, E); }
        { pg8::Gemm g{(const bf16_t*)(ws + WS_PROJ) + PJ_CKV, (const bf16_t*)(ws + WS_WKVUP), T, 2048, 512, DIN_P, 512}; pg8::StaticOrder So; So.init(T, 2048, G, cid);
          EpiUp<1> E{ssq + T, 1.0f / 512.0f, 1.0f, (bf16_t*)(ws + WS_KN), KNW, cs, nullptr};
          pg8::gemm_phase<EpiUp<1>>(lds, g, So, E); }
        { pg8::Gemm g{(const bf16_t*)(ws + WS_WKVUP) + (size_t)2048 * 512, (const bf16_t*)(ws + WS_PROJ) + PJ_CKV, 2048, T, 512, 512, DIN_P}; pg8::StaticOrder So; So.init(2048, T, G, cid);
          EpiVt E{(bf16_t*)(ws + WS_VT), 2048, ssq + T, 1.0f / 512.0f};
          pg8::gemm_phase<EpiVt>(lds, g, So, E); }
        REPSYNC(2); }
        SEAM(2);
    }
    if (IN(3)) { LOADP();
        mla_phase(P, lds, ssq); swa_phase(P, lds, ssq);
        SEAM(3);
    }
    if (IN(5)) { LOADP();
        for (int _r = 0; _r < NREP(5); ++_r) {
        pg8::Gemm g{(const bf16_t*)(ws + WS_R0), (const bf16_t*)(ws + WS_WO), T, D, 2048, D, D}; pg8::StaticOrder So; So.init(T, D, G, cid, 1);
        EpiBf16Ssq<true> E{(bf16_t*)(ws + WS_Y), ssq + 4 * T + (_r ? 6 * T : 0), ssq + 2 * T, ssq + 3 * T};
        pg8::gemm_phase<EpiBf16Ssq<true>>(lds, g, So, E); REPSYNC(5); }
        SEAM(5);
    }
    if (IN(6)) { LOADP(); for (int _r = 0; _r < NREP(6); ++_r) { x1_phase(P); REPSYNC(6); } SEAM(6); }
    if (IN(7)) { LOADP();
        for (int _r = 0; _r < NREP(7); ++_r) {
        pg8::Gemm g{(const bf16_t*)(ws + WS_R0), (const bf16_t*)(ws + WS_WGU), T, 2 * DFF, D, D, D}; pg8::StaticOrder So; So.init(T, 2 * DFF, G, cid);
        EpiSwiglu E{(bf16_t*)(ws + WS_ACT)};
        pg8::gemm_phase<EpiSwiglu>(lds, g, So, E); REPSYNC(7); }
        {
            const int t0 = (64 * 86) % G, gp = t0 ? G - t0 : G, cp = t0 ? cid - t0 : cid;
            if (cp >= 0) {
                pg8::Gemm g{(const bf16_t*)(ws + WS_PB), (const bf16_t*)(ws + WS_WPP), T, D, PLE, PLE, PLE}; pg8::StaticOrder So; So.init(T, D, gp, cp);
                EpiBf16 E{(bf16_t*)(ws + WS_PP), D};
                pg8::gemm_phase<EpiBf16>(lds, g, So, E);
            }
        }
        SEAM(7);
    }
    if (IN(8)) { LOADP();
        for (int _r = 0; _r < NREP(8); ++_r) {
        pg8::Gemm g{(const bf16_t*)(ws + WS_ACT), (const bf16_t*)(ws + WS_WDN), T, D, DFF, DFF, DFF}; pg8::StaticOrder So; So.init(T, D, G, cid);
        EpiBf16Ssq<false> E{(bf16_t*)(ws + WS_F), ssq + 5 * T + (_r ? 6 * T : 0), nullptr, nullptr};
        pg8::gemm_phase<EpiBf16Ssq<false>>(lds, g, So, E); REPSYNC(8); }
        SEAM(8);
    }
    if (IN(9)) { LOADP(); x2_phase(P); SEAM(9); }
    if (IN(10)) { LOADP();
        { pg8::Gemm g{(const bf16_t*)(ws + WS_X2B), (const bf16_t*)(ws + WS_WPG), T, D, D, D, D}; pg8::StaticOrder So; So.init(T, D, G, cid);
          EpiPle E{P.out, (const bf16_t*)(ws + WS_PP), (const bf16_t*)(ws + WS_X2B)};
          pg8::gemm_phase<EpiPle>(lds, g, So, E); }
    }
#undef IN
#undef SEAM
#undef NREP
#undef REPSYNC
}

extern "C" void kernel_launch(void* const* d_in, const int* in_sizes, int n_in, void* d_out, int out_size, void* d_ws, size_t ws_size, hipStream_t stream) {
    static int grid = 0;
    if (grid == 0) {
        if (n_in != 21 || out_size != T * D || ws_size < WS_TOTAL) { fprintf(stderr, "kernel_launch: unexpected shapes (n_in %d out %d ws %zu)\n", n_in, out_size, ws_size); grid = -1; return; }
        int dev = 0, cus = 0, per_cu = 0;
        hipGetDevice(&dev);
        hipDeviceGetAttribute(&cus, hipDeviceAttributeMultiprocessorCount, dev);
        if (hipFuncSetAttribute((const void*)mk_fwd, hipFuncAttributeMaxDynamicSharedMemorySize, LDS_BYTES) != hipSuccess) { fprintf(stderr, "kernel_launch: hipFuncSetAttribute failed\n"); grid = -1; return; }
        if (hipOccupancyMaxActiveBlocksPerMultiprocessor(&per_cu, (const void*)mk_fwd, 512, LDS_BYTES) != hipSuccess || per_cu < 1) { fprintf(stderr, "kernel_launch: occupancy query says %d\n", per_cu); per_cu = 1; }
        (void)hipGetLastError();
        grid = cus * 1;
        if (grid <= 0) grid = 256;
    }
    if (grid < 0) return;
    Params a{};
    for (int i = 0; i < 21; ++i) a.in[i] = d_in[i];
    a.out = (float*)d_out; a.ws = (unsigned char*)d_ws;
#if MK_SINGLE
    if (hipMemsetAsync((char*)d_ws + WS_KR, 0, 16384, stream) != hipSuccess) { fprintf(stderr, "kernel_launch: hipMemsetAsync failed\n"); return; }
    a.ph_lo = 0; a.ph_hi = NPHASE;
    void* args[] = {&a};
    hipError_t e = hipLaunchCooperativeKernel((const void*)mk_fwd, dim3(grid), dim3(512), args, LDS_BYTES, stream);
    if (e != hipSuccess) fprintf(stderr, "cooperative launch failed: %s (grid %d)\n", hipGetErrorString(e), grid);
#else
    for (int ph = 0; ph < NPHASE; ++ph) {
        a.ph_lo = ph; a.ph_hi = ph + 1;
        hipLaunchKernelGGL(mk_fwd, dim3(grid), dim3(512), LDS_BYTES, stream, a);
    }
#endif
}
```

```cpp
#include <hip/hip_runtime.h>
#include <hip/hip_cooperative_groups.h>
#include <cstdio>
#include <cstdint>
namespace cg = cooperative_groups;

#ifndef PROBE_PH
#define PROBE_PH -1
#define PROBE_N 1
#endif
#ifndef MK_SINGLE
#define MK_SINGLE 1
#endif

#define DI __device__ __forceinline__
#define LAS __attribute__((address_space(3)))
typedef unsigned short bf16_t;
typedef short bf16x8 __attribute__((ext_vector_type(8)));
typedef float f32x4 __attribute__((ext_vector_type(4)));
typedef float f32x2 __attribute__((ext_vector_type(2)));
typedef float f32x16 __attribute__((ext_vector_type(16)));
typedef unsigned u32x4 __attribute__((ext_vector_type(4)));
typedef unsigned u32x2 __attribute__((ext_vector_type(2)));
typedef __bf16 bf16x2_t __attribute__((ext_vector_type(2)));

constexpr int NB = 2, S = 8192, T = NB * S, D = 4096, DFF = 11008, PLE = 256;
constexpr int DIN_P = 4352;
constexpr int QW = 3072, KNW = 2048;
constexpr float EPS = 1e-6f;
constexpr float LOG2E = 1.4426950408889634f;
constexpr float MLA_QSCALE = 0.10411754627697264f;
constexpr float SWA_QSCALE = 0.18033688011112042f;
constexpr int LDS_BYTES = 163840;
constexpr int VPITCH = S + 128;

constexpr int PJ_CQ = 0, PJ_CKV = 1024, PJ_QS = 1536, PJ_KS = 3584, PJ_VS = 3840, PJ_KR = 4096;

constexpr size_t al256(size_t x) { return (x + 255) & ~(size_t)255; }
constexpr size_t WS_WIN = 0;
constexpr size_t WS_WQUP = WS_WIN + (size_t)DIN_P * D * 2;
constexpr size_t WS_WKVUP = WS_WQUP + (size_t)QW * 1024 * 2;
constexpr size_t WS_WO = WS_WKVUP + (size_t)4096 * 512 * 2;
constexpr size_t WS_WGU = WS_WO + (size_t)D * D * 2;
constexpr size_t WS_WDN = WS_WGU + (size_t)2 * DFF * D * 2;
constexpr size_t WS_WPG = WS_WDN + (size_t)D * DFF * 2;
constexpr size_t WS_WPP = WS_WPG + (size_t)D * D * 2;
constexpr size_t WS_CS = WS_WPP + (size_t)D * PLE * 2;
constexpr size_t WS_SSQ = WS_CS + (size_t)T * 32 * 8;
constexpr size_t WS_PB = WS_SSQ + (size_t)12 * T * 4;
constexpr size_t WS_KR = WS_PB + (size_t)T * PLE * 2;
constexpr size_t WS_KRP = WS_KR + 16384;
constexpr size_t WS_VTS = WS_KRP + (size_t)4 * T * 64 * 4;
constexpr size_t WS_R0 = al256(WS_VTS + (size_t)NB * 4 * 64 * VPITCH * 2);
constexpr size_t WS_B = WS_R0 + (size_t)T * D * 2;
constexpr size_t WS_PROJ = WS_B;
constexpr size_t WS_Q = WS_PROJ + (size_t)T * DIN_P * 2;
constexpr size_t WS_KN = WS_Q + (size_t)T * QW * 2;
constexpr size_t WS_VT = WS_KN + (size_t)T * 3072 * 2;
constexpr size_t WS_VT_END = WS_VT + (size_t)NB * 2048 * VPITCH * 2;
constexpr size_t WS_Y = WS_B;
constexpr size_t WS_TOTAL = (size_t)1 << 30;
constexpr size_t WS_ACT = WS_TOTAL - (size_t)T * DFF * 2;
constexpr size_t WS_F = WS_R0;
constexpr size_t WS_X2B = WS_ACT;
constexpr size_t WS_PP = WS_B;
static_assert(WS_VT_END <= WS_TOTAL, "ws");
static_assert(WS_Y + (size_t)T * D * 4 <= WS_TOTAL, "ws");
static_assert(WS_F + (size_t)T * D * 4 <= WS_ACT, "ws");
static_assert(WS_R0 + (size_t)T * D * 2 <= WS_ACT, "ws");
static_assert(WS_PP + (size_t)T * D * 2 <= WS_ACT, "ws");

DI unsigned pk2(float a, float b) { f32x2 v = {a, b}; return __builtin_bit_cast(unsigned, __builtin_convertvector(v, bf16x2_t)); }
DI bf16_t f2bf(float a) { return (bf16_t)(pk2(a, 0.f) & 0xffffu); }
DI float bflo(unsigned u) { return __uint_as_float(u << 16); }
DI float bfhi(unsigned u) { return __uint_as_float(u & 0xffff0000u); }
DI float wave_sum(float v) {
#pragma unroll
    for (int o = 1; o < 64; o <<= 1) v += __shfl_xor(v, o);
    return v;
}
DI float fast_exp2(float x) { return __builtin_amdgcn_exp2f(x); }
DI float fast_rcp(float x) { return __builtin_amdgcn_rcpf(x); }
DI float sigmoidf_(float v) { return fast_rcp(1.0f + fast_exp2(-v * LOG2E)); }
DI int my_tid() { int t = threadIdx.x; asm volatile("" : "+v"(t)); return t; }
DI float xhalf_max(float v) { const auto r = __builtin_amdgcn_permlane32_swap(__float_as_uint(v), __float_as_uint(v), false, false); return fmaxf(__uint_as_float(r[0]), __uint_as_float(r[1])); }
DI const unsigned char* uni_ptr(const unsigned char* p) { const unsigned long long v = (unsigned long long)p; const unsigned lo = __builtin_amdgcn_readfirstlane((unsigned)v), hi = __builtin_amdgcn_readfirstlane((unsigned)(v >> 32)); return (const unsigned char*)(((unsigned long long)hi << 32) | lo); }
DI void dma16(const unsigned char* sbase, unsigned voff, unsigned ldsaddr) { asm volatile("s_mov_b32 m0, %0\n\ts_nop 0\n\tglobal_load_lds_dwordx4 %1, %2" :: "s"(ldsaddr), "v"(voff), "s"(sbase) : "memory"); }
DI int pi32(int i) { return (i & ~12) | ((i & 4) << 1) | ((i & 8) >> 1); }


#define XB_TMO      128
#define XB_XCNT(j)  (256  + 64 * (j))
#define XB_XSUB(j)  (1280 + 64 * (j))
#define XB_XGEN(j)  (2304 + 64 * (j))
#define XB_TOP      3328
#define XB_TOPGEN   3392
#define XB_SLOT(w)  (3456 + 2 * (w))
#define XB_WORDS    4096
#define XB_SPIN_CAP (1u << 20)
DI unsigned xb_ld(unsigned* p) { return __hip_atomic_load(p, __ATOMIC_RELAXED, __HIP_MEMORY_SCOPE_AGENT); }
DI unsigned xb_add(unsigned* p, unsigned v) { return __hip_atomic_fetch_add(p, v, __ATOMIC_RELAXED, __HIP_MEMORY_SCOPE_AGENT); }
DI unsigned xb_xcc_id() { return (unsigned)__builtin_amdgcn_s_getreg((3 << 11) | 20) & 0xFu; }
#define XB_SPIN(cond, bar) do { unsigned _sp = 0; while (cond) { __builtin_amdgcn_s_sleep(1); \
    if ((++_sp & 255u) == 0u) { if (xb_ld(&(bar)[XB_TMO])) break; if (_sp > XB_SPIN_CAP) { xb_add(&(bar)[XB_TMO], 1u); break; } } } } while (0)
DI void xcd_barrier_post(unsigned* bar) { if (threadIdx.x == 0) (void)xb_add(&bar[XB_XCNT(xb_xcc_id())], 1u); }
DI void xcd_barrier(unsigned* bar) {
    asm volatile("s_waitcnt vmcnt(0) lgkmcnt(0)" ::: "memory");
    __syncthreads();
    if (threadIdx.x == 0) {
        const unsigned x = xb_xcc_id(), G = gridDim.x;
        unsigned nloc = xb_ld(&bar[XB_SLOT(blockIdx.x)]), nx = xb_ld(&bar[XB_SLOT(blockIdx.x) + 1]);
        if (nloc == 0u) {
            unsigned sum, cnt, mine, sp = 0u;
            for (;;) {
                sum = 0u; cnt = 0u; mine = 0u;
#pragma unroll
                for (unsigned j = 0; j < 16; ++j) { const unsigned c = xb_ld(&bar[XB_XCNT(j)]); sum += c; cnt += (c > 0u) ? 1u : 0u; mine = (j == x) ? c : mine; }
                if (sum == G) break;
                __builtin_amdgcn_s_sleep(1);
                if ((++sp & 255u) == 0u) { if (xb_ld(&bar[XB_TMO])) break; if (sp > XB_SPIN_CAP) { xb_add(&bar[XB_TMO], 1u); break; } }
            }
            nloc = mine > 0u ? mine : 1u; nx = cnt > 0u ? cnt : 1u;
            __hip_atomic_store(&bar[XB_SLOT(blockIdx.x)], nloc, __ATOMIC_RELAXED, __HIP_MEMORY_SCOPE_AGENT); __hip_atomic_store(&bar[XB_SLOT(blockIdx.x) + 1], nx, __ATOMIC_RELAXED, __HIP_MEMORY_SCOPE_AGENT);
        }
        const unsigned old = xb_add(&bar[XB_XSUB(x)], 1u);
        const unsigned gen = old / nloc;
        if (old + 1u == (gen + 1u) * nloc) {
            __builtin_amdgcn_fence(__ATOMIC_RELEASE, "agent");
            asm volatile("s_waitcnt vmcnt(0)" ::: "memory");
            const unsigned og = xb_add(&bar[XB_TOP], 1u);
            const unsigned tg = og / nx;
            if (og + 1u == (tg + 1u) * nx) xb_add(&bar[XB_TOPGEN], 1u);
            else XB_SPIN(xb_ld(&bar[XB_TOPGEN]) == tg, bar);
            __builtin_amdgcn_fence(__ATOMIC_ACQUIRE, "agent");
            xb_add(&bar[XB_XGEN(x)], 1u);
            asm volatile("s_waitcnt vmcnt(0)" ::: "memory");
        } else {
            XB_SPIN(xb_ld(&bar[XB_XGEN(x)]) == gen, bar);
            __builtin_amdgcn_fence(__ATOMIC_ACQUIRE, "agent");
            asm volatile("s_waitcnt vmcnt(0)" ::: "memory");
        }
    }
    __syncthreads();
}

namespace pg8 {
constexpr int BM = 256, BK = 64, HALF = 128, HTB = HALF * BK * 2, STAGE_BYTES = 8 * HTB, NXCD = 8, WGM = 8;
DI int lds_byte(int r, int c) { const int st = (r >> 4) * 2 + (c >> 5), rr = r & 15, cc = c & 31, ob = rr * 64 + cc * 2; return st * 1024 + (ob ^ (((ob >> 9) & 1) << 5)); }
DI void stage_rc(int b, int& R, int& C) { const int st = b / 1024, sb = b % 1024, swz = sb ^ (((sb >> 9) & 1) << 5); R = (st >> 1) * 16 + swz / 64; C = (st & 1) * 32 + (swz % 64) / 2; }
DI int perm32(int rho) { const int n = rho >> 4, i = rho & 15; return 8 * (i >> 2) + 4 * n + (i & 3); }

struct Unit { int pm, pn, half; };
struct Gemm { const bf16_t* A; const bf16_t* Bt; int M, N, K, lda, ldb; };

struct StaticOrder {
    int nM, nN, nwg, G, c, split;
    DI void init(int M, int N, int G_, int c_, int split_ = 0) { nM = M / BM; nN = N / BM; nwg = nM * nN; G = G_; c = c_; split = split_; }
    DI bool next(int i, Unit& u) const {
        if (split == 2) { const long L4 = (long)i * G + c; if (L4 >= 4L * nM) return false; u.pm = (int)(L4 >> 2); u.pn = 0; u.half = (int)(L4 & 3); return true; }
        u.half = split ? (i & 1) : 1; if (split) i >>= 1;
        const long L = (long)i * G + c; if (L >= nwg) return false;
        int wgid = (int)L; { const int q = nwg / NXCD, r = nwg % NXCD, xcd = wgid % NXCD, off = wgid / NXCD; wgid = (xcd < r ? xcd * (q + 1) : r * (q + 1) + (xcd - r) * q) + off; }
        const int nig = WGM * nN, gid = wgid / nig, fm = gid * WGM, gsz = (nM - fm) < WGM ? (nM - fm) : WGM;
        u.pm = fm + ((wgid % nig) % gsz); u.pn = (wgid % nig) / gsz; return true;
    }
};

template <class Epi>
DI void gemm_phase(LAS unsigned char* lds, const Gemm g, const StaticOrder& S, const Epi& E) {
    const int tid = my_tid(), wid = __builtin_amdgcn_readfirstlane(tid >> 6), lane = tid & 63, wr = wid >> 2, wc = wid & 3, fr = lane & 15, fq = lane >> 4;
    int K = g.K; asm volatile("" : "+s"(K));
    const int nt = K / BK;
    unsigned voffA[2], voffB[2];
#pragma unroll
    for (int i = 0; i < 2; ++i) { int R, C; stage_rc(tid * 16 + i * 8192, R, C); const int Rb = Epi::PERM ? ((R & ~31) + perm32(R & 31)) : R;
        voffA[i] = (unsigned)(R * g.lda + C) * 2u; voffB[i] = (unsigned)(Rb * g.ldb + C) * 2u; }
    const size_t kstep = (size_t)(BK * 2);
    const size_t hstepA = (size_t)HALF * g.lda * 2, hstepB = (size_t)HALF * g.ldb * 2;
    const size_t tstepA = 2 * hstepA, tstepB = 2 * hstepB;
    const unsigned ldsw = (unsigned)wid * 1024u;
    const int aoff = lds_byte(wr * 64 + fr, fq * 8), boff = lds_byte(wc * 32 + fr, fq * 8);
#define PG8_SA(b, h) (((b) * 2 + (h)) * HTB)
#define PG8_SB(b, h) ((4 + (b) * 2 + (h)) * HTB)
#define PG8_STAGE(bufoff, gbase, voff) do { _Pragma("unroll") for (int _i = 0; _i < 2; ++_i) \
        __builtin_amdgcn_global_load_lds((const unsigned*)((const char*)(gbase) + (voff)[_i]), (LAS unsigned*)(lds + (bufoff) + ldsw + _i * 8192), 16, 0, 0); } while (0)
#define PG8_LDA(dst, b, h) do { _Pragma("unroll") for (int m = 0; m < 4; ++m) _Pragma("unroll") for (int k = 0; k < 2; ++k) dst[m][k] = *(const LAS bf16x8*)(lds + PG8_SA(b, h) + aoff + m * 2048 + k * 1024); } while (0)
#define PG8_LDB(dst, b, h) do { _Pragma("unroll") for (int n = 0; n < 2; ++n) _Pragma("unroll") for (int k = 0; k < 2; ++k) dst[n][k] = *(const LAS bf16x8*)(lds + PG8_SB(b, h) + boff + n * 2048 + k * 1024); } while (0)
#define PG8_MMA(ai, bj, At, Bt) do { __builtin_amdgcn_s_setprio(1); _Pragma("unroll") for (int m = 0; m < 4; ++m) _Pragma("unroll") for (int n = 0; n < 2; ++n) _Pragma("unroll") for (int k = 0; k < 2; ++k) \
        acc[ai][bj][m][n] = __builtin_amdgcn_mfma_f32_16x16x32_bf16(Bt[n][k], At[m][k], acc[ai][bj][m][n], 0, 0, 0); __builtin_amdgcn_s_setprio(0); } while (0)
#define PG8_WAIT_V(n) asm volatile("s_waitcnt vmcnt(" #n ")" ::: "memory")
#define PG8_WAIT_L(n) asm volatile("s_waitcnt lgkmcnt(" #n ")" ::: "memory")
#define PG8_BAR __builtin_amdgcn_s_barrier()
#define PG8_SCHED __builtin_amdgcn_sched_barrier(0)
    Unit cur, nxt; int ui = 0;
    if (!S.next(0, cur)) return;
    f32x4 acc[2][2][4][2];
#pragma unroll
    for (int a = 0; a < 2; ++a)
#pragma unroll
        for (int b = 0; b < 2; ++b)
#pragma unroll
            for (int m = 0; m < 4; ++m)
#pragma unroll
                for (int n = 0; n < 2; ++n) acc[a][b][m][n] = (f32x4){0.f, 0.f, 0.f, 0.f};
    bf16x8 At[4][2], B0[2][2], B1[2][2];
#define PG8_KOFF(u) ((Epi::MIDK || Epi::KSPLIT) ? (size_t)(u).half * (size_t)K * 2 : (size_t)0)
    const char* cA = (const char*)g.A + (size_t)cur.pm * tstepA + PG8_KOFF(cur); const char* cB = (const char*)g.Bt + (size_t)cur.pn * tstepB + PG8_KOFF(cur);
    PG8_STAGE(PG8_SB(0, 0), cB, voffB); PG8_STAGE(PG8_SB(0, 1), cB + hstepB, voffB); PG8_STAGE(PG8_SA(0, 0), cA, voffA); PG8_STAGE(PG8_SA(0, 1), cA + hstepA, voffA);
    if (wr == 1) PG8_BAR;
    PG8_WAIT_V(2); PG8_BAR;
    PG8_STAGE(PG8_SB(1, 0), cB + kstep, voffB); PG8_STAGE(PG8_SA(1, 0), cA + kstep, voffA); PG8_STAGE(PG8_SB(1, 1), cB + hstepB + kstep, voffB);
    PG8_WAIT_V(6); PG8_BAR;
    for (;;) {
        const bool has_next = S.next(ui + 1, nxt);
        const char* nA = has_next ? (const char*)g.A + (size_t)nxt.pm * tstepA + PG8_KOFF(nxt) : cA; const char* nB = has_next ? (const char*)g.Bt + (size_t)nxt.pn * tstepB + PG8_KOFF(nxt) : cB;
        for (int t = 0; t < nt; t += 2) {
            const bool last = (t == nt - 2);
            const char* a1 = cA + (size_t)(t + 1) * kstep;
            const char* a2 = last ? nA : cA + (size_t)(t + 2) * kstep; const char* b2 = last ? nB : cB + (size_t)(t + 2) * kstep;
            const char* a3 = a2 + kstep; const char* b3 = b2 + kstep;
            PG8_LDB(B0, 0, 0); PG8_LDB(B1, 0, 1); PG8_SCHED; PG8_LDA(At, 0, 0); PG8_STAGE(PG8_SA(1, 1), a1 + hstepA, voffA);
            PG8_WAIT_V(8); PG8_WAIT_L(0); PG8_BAR; PG8_MMA(0, 0, At, B0); PG8_MMA(0, 1, At, B1); PG8_BAR; PG8_SCHED;
            PG8_LDA(At, 0, 1); PG8_STAGE(PG8_SB(0, 0), b2, voffB); PG8_STAGE(PG8_SB(0, 1), b2 + hstepB, voffB); PG8_STAGE(PG8_SA(0, 0), a2, voffA);
            PG8_WAIT_V(8); PG8_WAIT_L(0); PG8_BAR; PG8_MMA(1, 0, At, B0); PG8_MMA(1, 1, At, B1); PG8_BAR; PG8_SCHED;
            PG8_LDB(B0, 1, 0); PG8_LDB(B1, 1, 1); PG8_SCHED; PG8_LDA(At, 1, 0); PG8_STAGE(PG8_SA(0, 1), a2 + hstepA, voffA);
            PG8_WAIT_V(8); PG8_WAIT_L(0); PG8_BAR; PG8_MMA(0, 0, At, B0); PG8_MMA(0, 1, At, B1); PG8_BAR; PG8_SCHED;
            PG8_LDA(At, 1, 1); PG8_STAGE(PG8_SB(1, 0), b3, voffB); PG8_STAGE(PG8_SB(1, 1), b3 + hstepB, voffB); PG8_STAGE(PG8_SA(1, 0), a3, voffA);
            PG8_WAIT_V(8); PG8_WAIT_L(0); PG8_BAR; PG8_MMA(1, 0, At, B0); PG8_MMA(1, 1, At, B1); PG8_BAR; PG8_SCHED;
        }
        if (wr == 0) PG8_BAR;
        bool keep = false;
        if constexpr (Epi::MIDK) { if (cur.half == 0) { E.mid(acc, cur, wr, wc, fr, fq); keep = true; } else E(acc, cur, wr, wc, fr, fq); } else E(acc, cur, wr, wc, fr, fq);
        if (!has_next) break;
        if (!keep)
#pragma unroll
        for (int a = 0; a < 2; ++a)
#pragma unroll
            for (int b = 0; b < 2; ++b)
#pragma unroll
                for (int m = 0; m < 4; ++m)
#pragma unroll
                    for (int n = 0; n < 2; ++n) acc[a][b][m][n] = (f32x4){0.f, 0.f, 0.f, 0.f};
        cur = nxt; cA = nA; cB = nB; ++ui;
        if (wr == 1) PG8_BAR;
    }
    PG8_WAIT_V(0);
    PG8_BAR;
#undef PG8_SA
#undef PG8_KOFF
#undef PG8_SB
#undef PG8_STAGE
#undef PG8_LDA
#undef PG8_LDB
#undef PG8_MMA
#undef PG8_WAIT_V
#undef PG8_WAIT_L
#undef PG8_BAR
#undef PG8_SCHED
}
}
using pg8::Unit;

typedef const f32x4 (&AccRef)[2][2][4][2];

DI float row_sq(AccRef acc, int ai, int m) {
    float s = 0.f;
#pragma unroll
    for (int bj = 0; bj < 2; ++bj)
#pragma unroll
        for (int n = 0; n < 2; ++n) { const f32x4 v = acc[ai][bj][m][n]; s += (v[0] * v[0] + v[1] * v[1]) + (v[2] * v[2] + v[3] * v[3]); }
    s += __shfl_xor(s, 16); s += __shfl_xor(s, 32);
    return s;
}
DI u32x4 pack8(f32x4 v0, f32x4 v1) { u32x4 w; w.x = pk2(v0[0], v0[1]); w.y = pk2(v0[2], v0[3]); w.z = pk2(v1[0], v1[1]); w.w = pk2(v1[2], v1[3]); return w; }
DI void rope8(f32x4& v0, f32x4& v1, const f32x2* cs) {
    const f32x4 c01 = *(const f32x4*)cs, c23 = *(const f32x4*)(cs + 2);
    f32x4 r0, r1;
    r0[0] = v0[0] * c01[0] - v0[1] * c01[1]; r0[1] = v0[0] * c01[1] + v0[1] * c01[0];
    r0[2] = v0[2] * c01[2] - v0[3] * c01[3]; r0[3] = v0[2] * c01[3] + v0[3] * c01[2];
    r1[0] = v1[0] * c23[0] - v1[1] * c23[1]; r1[1] = v1[0] * c23[1] + v1[1] * c23[0];
    r1[2] = v1[2] * c23[2] - v1[3] * c23[3]; r1[3] = v1[2] * c23[3] + v1[3] * c23[2];
    v0 = r0; v1 = r1;
}

struct EpiIn {
    static constexpr bool PERM = true, MIDK = false, KSPLIT = false;
    bf16_t* proj; float* ssq_q; float* ssq_kv; bf16_t* vts; bf16_t* kr; const f32x2* cs;
    DI void operator()(AccRef acc, const Unit& u, int wr, int wc, int fr, int fq) const {
        const int row0 = u.pm * 256 + wr * 64 + fr, colt = u.pn * 256, lc0 = wc * 32 + 8 * fq;
#pragma unroll
        for (int ai = 0; ai < 2; ++ai)
#pragma unroll
            for (int m = 0; m < 4; ++m) {
                const int row = row0 + ai * 128 + m * 16;
                bf16_t* rp = proj + (size_t)row * DIN_P + colt + lc0;
#pragma unroll
                for (int bj = 0; bj < 2; ++bj) *(u32x4*)(rp + bj * 128) = pack8(acc[ai][bj][m][0], acc[ai][bj][m][1]);
            }
        if (u.pn < 6) {
            float* sq = u.pn < 4 ? ssq_q : ssq_kv;
#pragma unroll
            for (int ai = 0; ai < 2; ++ai)
#pragma unroll
                for (int m = 0; m < 4; ++m) { const float s = row_sq(acc, ai, m); if (fq == 0) unsafeAtomicAdd(sq + row0 + ai * 128 + m * 16, s); }
        }
    }
};

struct EpiKr {
    static constexpr bool PERM = true, MIDK = false, KSPLIT = true;
    float* krp;
    DI void operator()(AccRef acc, const Unit& u, int wr, int wc, int fr, int fq) const {
        if (wc >= 2) return;
        const int row0 = u.pm * 256 + wr * 64 + fr, lc0 = wc * 32 + 8 * fq;
#pragma unroll
        for (int ai = 0; ai < 2; ++ai)
#pragma unroll
            for (int m = 0; m < 4; ++m) {
                float* rp = krp + ((size_t)u.half * T + row0 + ai * 128 + m * 16) * 64 + lc0;
                *(f32x4*)rp = acc[ai][0][m][0]; *(f32x4*)(rp + 4) = acc[ai][0][m][1];
            }
    }
};

struct EpiVt {
    static constexpr bool PERM = true, MIDK = false, KSPLIT = false;
    bf16_t* out; int rows_per_batch; const float* ssq; float inv_dim;
    DI void operator()(AccRef acc, const Unit& u, int wr, int wc, int fr, int fq) const {
        const int n0 = u.pm * 256 + wr * 64 + fr, t0 = u.pn * 256 + wc * 32 + 8 * fq, b = t0 >> 13, s0 = t0 & (S - 1);
        f32x4 sc[2][2];
#pragma unroll
        for (int bj = 0; bj < 2; ++bj)
#pragma unroll
            for (int n = 0; n < 2; ++n) {
                if (ssq) { const f32x4 q = *(const f32x4*)(ssq + t0 + bj * 128 + 4 * n);
#pragma unroll
                    for (int j = 0; j < 4; ++j) sc[bj][n][j] = rsqrtf(q[j] * inv_dim + EPS);
                } else sc[bj][n] = (f32x4){1.f, 1.f, 1.f, 1.f};
            }
#pragma unroll
        for (int ai = 0; ai < 2; ++ai)
#pragma unroll
            for (int m = 0; m < 4; ++m) {
                bf16_t* rp = out + ((size_t)(b * rows_per_batch + n0 + ai * 128 + m * 16)) * VPITCH + s0;
#pragma unroll
                for (int bj = 0; bj < 2; ++bj) *(u32x4*)(rp + bj * 128) = pack8(acc[ai][bj][m][0] * sc[bj][0], acc[ai][bj][m][1] * sc[bj][1]);
            }
    }
};

template <int MODE> struct EpiUp {
    static constexpr bool PERM = true, MIDK = false, KSPLIT = false;
    const float* ssq; float inv_dim, mul; bf16_t* out; int ldc; const f32x2* cs; bf16_t* vt;
    template <bool ROPE> DI void run(AccRef acc, const Unit& u, int wr, int wc, int fr, int fq) const {
        const int row0 = u.pm * 256 + wr * 64 + fr, colt = u.pn * 256, lc0 = wc * 32 + 8 * fq;
        float sc[2][4];
#pragma unroll
        for (int ai = 0; ai < 2; ++ai)
#pragma unroll
            for (int m = 0; m < 4; ++m) sc[ai][m] = ssq[row0 + ai * 128 + m * 16];
#pragma unroll
        for (int ai = 0; ai < 2; ++ai) {
            f32x4 c01[4], c23[4];
            if (ROPE) {
#pragma unroll
                for (int m = 0; m < 4; ++m) { const f32x2* cp = cs + (size_t)(row0 + ai * 128 + m * 16) * 32 + (wc & 1) * 16 + 4 * fq; c01[m] = *(const f32x4*)cp; c23[m] = *(const f32x4*)(cp + 2); }
            }
#pragma unroll
            for (int m = 0; m < 4; ++m) {
                const int row = row0 + ai * 128 + m * 16;
                const float scl = rsqrtf(sc[ai][m] * inv_dim + EPS) * mul;
#pragma unroll
                for (int bj = 0; bj < 2; ++bj) {
                    f32x4 v0 = acc[ai][bj][m][0] * scl, v1 = acc[ai][bj][m][1] * scl;
                    if (ROPE) {
                        const f32x4 a = c01[m], bq = c23[m]; f32x4 r0, r1;
                        r0[0] = v0[0] * a[0] - v0[1] * a[1]; r0[1] = v0[0] * a[1] + v0[1] * a[0];
                        r0[2] = v0[2] * a[2] - v0[3] * a[3]; r0[3] = v0[2] * a[3] + v0[3] * a[2];
                        r1[0] = v1[0] * bq[0] - v1[1] * bq[1]; r1[1] = v1[0] * bq[1] + v1[1] * bq[0];
                        r1[2] = v1[2] * bq[2] - v1[3] * bq[3]; r1[3] = v1[2] * bq[3] + v1[3] * bq[2];
                        v0 = r0; v1 = r1;
                    }
                    if (MODE == 1) *(u32x4*)(out + (size_t)row * 3072 + (u.pn * 2 + bj) * 192 + lc0) = pack8(v0, v1);
                    else *(u32x4*)(out + (size_t)row * ldc + colt + bj * 128 + lc0) = pack8(v0, v1);
                }
            }
        }
    }
    DI void operator()(AccRef acc, const Unit& u, int wr, int wc, int fr, int fq) const {
        if (MODE == 0 && u.pn >= 8) run<true>(acc, u, wr, wc, fr, fq); else run<false>(acc, u, wr, wc, fr, fq);
    }
};

template <bool MIDK_> struct EpiBf16Ssq {
    static constexpr bool PERM = true, MIDK = MIDK_, KSPLIT = false;
    bf16_t* C; float* ssq; const float* ssqA; const float* ssqB;
    DI void mid(f32x4 (&acc)[2][2][4][2], const Unit& u, int wr, int wc, int fr, int fq) const {
        const int row0 = u.pm * 256 + wr * 64 + fr;
#pragma unroll
        for (int ai = 0; ai < 2; ++ai)
#pragma unroll
            for (int m = 0; m < 4; ++m) {
                const int row = row0 + ai * 128 + m * 16;
                const float ratio = rsqrtf(ssqA[row] * (1.0f / 2048.0f) + EPS) * sqrtf(ssqB[row] * (1.0f / 2048.0f) + EPS);
#pragma unroll
                for (int bj = 0; bj < 2; ++bj)
#pragma unroll
                    for (int n = 0; n < 2; ++n) acc[ai][bj][m][n] *= ratio;
            }
    }
    DI void operator()(AccRef acc, const Unit& u, int wr, int wc, int fr, int fq) const {
        const int row0 = u.pm * 256 + wr * 64 + fr, col0 = u.pn * 256 + wc * 32 + 8 * fq;
        float sb[2][4];
        if (MIDK) {
#pragma unroll
            for (int ai = 0; ai < 2; ++ai)
#pragma unroll
                for (int m = 0; m < 4; ++m) sb[ai][m] = ssqB[row0 + ai * 128 + m * 16];
        }
#pragma unroll
        for (int ai = 0; ai < 2; ++ai)
#pragma unroll
            for (int m = 0; m < 4; ++m) {
                const int row = row0 + ai * 128 + m * 16;
                float sc = 1.0f;
                if (MIDK) sc = rsqrtf(sb[ai][m] * (1.0f / 2048.0f) + EPS);
                bf16_t* rp = C + (size_t)row * D + col0;
#pragma unroll
                for (int bj = 0; bj < 2; ++bj) *(u32x4*)(rp + bj * 128) = pack8(acc[ai][bj][m][0] * sc, acc[ai][bj][m][1] * sc);
                const float s = row_sq(acc, ai, m) * sc * sc; if (fq == 0) unsafeAtomicAdd(ssq + row, s);
            }
    }
};

struct EpiSwiglu {
    static constexpr bool PERM = true, MIDK = false, KSPLIT = false;
    bf16_t* act;
    DI void operator()(AccRef acc, const Unit& u, int wr, int wc, int fr, int fq) const {
        const int row0 = u.pm * 256 + wr * 64 + fr, col0 = u.pn * 128 + wc * 32 + 8 * fq;
#pragma unroll
        for (int ai = 0; ai < 2; ++ai)
#pragma unroll
            for (int m = 0; m < 4; ++m) {
                const int row = row0 + ai * 128 + m * 16;
                f32x4 r[2];
#pragma unroll
                for (int n = 0; n < 2; ++n)
#pragma unroll
                    for (int j = 0; j < 4; ++j) { const float gt = acc[ai][0][m][n][j], up = acc[ai][1][m][n][j]; r[n][j] = gt * sigmoidf_(gt) * up; }
                *(u32x4*)(act + (size_t)row * DFF + col0) = pack8(r[0], r[1]);
            }
    }
};

struct EpiBf16 {
    static constexpr bool PERM = true, MIDK = false, KSPLIT = false;
    bf16_t* out; int ldc;
    DI void operator()(AccRef acc, const Unit& u, int wr, int wc, int fr, int fq) const {
        const int row0 = u.pm * 256 + wr * 64 + fr, col0 = u.pn * 256 + wc * 32 + 8 * fq;
#pragma unroll
        for (int ai = 0; ai < 2; ++ai)
#pragma unroll
            for (int m = 0; m < 4; ++m) {
                bf16_t* rp = out + (size_t)(row0 + ai * 128 + m * 16) * ldc + col0;
#pragma unroll
                for (int bj = 0; bj < 2; ++bj) *(u32x4*)(rp + bj * 128) = pack8(acc[ai][bj][m][0], acc[ai][bj][m][1]);
            }
    }
};

struct EpiPle {
    static constexpr bool PERM = true, MIDK = false, KSPLIT = false;
    float* out; const bf16_t* pp; const bf16_t* x2b;
    DI void operator()(AccRef acc, const Unit& u, int wr, int wc, int fr, int fq) const {
        const int row0 = u.pm * 256 + wr * 64 + fr, col0 = u.pn * 256 + wc * 32 + 8 * fq;
#pragma unroll
        for (int ai = 0; ai < 2; ++ai) {
            u32x4 pv[4][2], xv[4][2];
#pragma unroll
            for (int m = 0; m < 4; ++m)
#pragma unroll
                for (int bj = 0; bj < 2; ++bj) { const size_t o = (size_t)(row0 + ai * 128 + m * 16) * D + col0 + bj * 128; pv[m][bj] = *(const u32x4*)(pp + o); xv[m][bj] = *(const u32x4*)(x2b + o); }
#pragma unroll
            for (int m = 0; m < 4; ++m)
#pragma unroll
                for (int bj = 0; bj < 2; ++bj) {
                    float* op = out + (size_t)(row0 + ai * 128 + m * 16) * D + col0 + bj * 128;
                    const u32x4 p4 = pv[m][bj], x4 = xv[m][bj];
                    const f32x4 a0 = acc[ai][bj][m][0], a1 = acc[ai][bj][m][1];
                    f32x4 x0, x1;
                    x0[0] = bflo(x4.x) + sigmoidf_(a0[0]) * bflo(p4.x); x0[1] = bfhi(x4.x) + sigmoidf_(a0[1]) * bfhi(p4.x);
                    x0[2] = bflo(x4.y) + sigmoidf_(a0[2]) * bflo(p4.y); x0[3] = bfhi(x4.y) + sigmoidf_(a0[3]) * bfhi(p4.y);
                    x1[0] = bflo(x4.z) + sigmoidf_(a1[0]) * bflo(p4.z); x1[1] = bfhi(x4.z) + sigmoidf_(a1[1]) * bfhi(p4.z);
                    x1[2] = bflo(x4.w) + sigmoidf_(a1[2]) * bflo(p4.w); x1[3] = bfhi(x4.w) + sigmoidf_(a1[3]) * bfhi(p4.w);
                    *(f32x4*)op = x0; *(f32x4*)(op + 4) = x1;
                }
        }
    }
};

struct TDesc { const float* src; int N; int c0; bf16_t* dst; int ldk; int n0; int perm; const float* rowscale; float colscale; const float* rowscale_hi; };

typedef const float __attribute__((address_space(1)))* gfp_t;
typedef const f32x4 __attribute__((address_space(1)))* gf4p_t;
DI void transpose_item(const TDesc& d, int kt, LAS float* scr, int lane) {
    const int k0 = kt * 64;
    const int lr = lane >> 4, lc = (lane & 15) * 4;
    f32x4 v[16]; float rsv[16];
    const gfp_t src = (gfp_t)(d.src + (size_t)(k0 + lr) * d.N + d.c0 + lc);
#pragma unroll
    for (int i = 0; i < 16; ++i) v[i] = *(gf4p_t)(src + (size_t)(4 * i) * d.N);
    if (d.rowscale) {
        const gfp_t rsp = (gfp_t)(((d.rowscale_hi && k0 >= 2048) ? d.rowscale_hi + (k0 - 2048) : d.rowscale + k0) + lr);
#pragma unroll
        for (int i = 0; i < 16; ++i) rsv[i] = rsp[4 * i] * d.colscale;
    } else {
#pragma unroll
        for (int i = 0; i < 16; ++i) rsv[i] = d.colscale;
    }
#pragma unroll
    for (int i = 0; i < 16; ++i) {
        LAS float* sp = scr + (4 * i + lr) * 65 + lc;
        sp[0] = v[i][0] * rsv[i]; sp[1] = v[i][1] * rsv[i]; sp[2] = v[i][2] * rsv[i]; sp[3] = v[i][3] * rsv[i];
    }
    asm volatile("s_waitcnt lgkmcnt(0)" ::: "memory");
    const int c = lane & 7;
#pragma unroll
    for (int j = 0; j < 8; ++j) {
        const int n = (lane >> 3) + 8 * j;
        const int sn = d.perm ? ((n >> 1) + 32 * (n & 1)) : n;
        const LAS float* s = scr + (8 * c) * 65 + sn;
        u32x4 o; o.x = pk2(s[0], s[65]); o.y = pk2(s[130], s[195]); o.z = pk2(s[260], s[325]); o.w = pk2(s[390], s[455]);
        *(u32x4 __attribute__((address_space(1)))*)(d.dst + (size_t)(d.n0 + n) * d.ldk + k0 + 8 * c) = o;
    }
    asm volatile("s_waitcnt lgkmcnt(0)" ::: "memory");
}

struct Ptrs {
    const float *x, *p; const int* pos; const float *g_attn_pre, *w_in, *g_qa, *w_qup, *g_kva, *w_kvup, *sinks, *g_mla, *g_swa, *w_o, *g_attn_post, *g_ffn_pre,
        *w_gate, *w_up, *w_down, *g_ffn_post, *w_pg, *w_pp;
    float* out; unsigned char* ws;
};

constexpr int IT_IN = 65 * 64, IT_QUP = 48 * 16, IT_KVUP = 64 * 8, IT_O = 64 * 64, IT_GU = 344 * 64, IT_DN = 64 * 172, IT_PG = 64 * 64, IT_PP = 64 * 4;
constexpr int IT_TOTAL = IT_IN + IT_QUP + IT_KVUP + IT_O + IT_GU + IT_DN + IT_PG + IT_PP;

DI void conv_item(const Ptrs& P, int it, LAS float* scr, int lane) {
    TDesc d; int kt; d.perm = 0; d.rowscale = nullptr; d.colscale = 1.0f; d.rowscale_hi = nullptr;
    unsigned char* ws = P.ws;
    if (it < IT_IN) { const int jt = it % 65; kt = it / 65; d.src = P.w_in; d.N = 4160; d.dst = (bf16_t*)(ws + WS_WIN); d.ldk = D; d.n0 = jt * 64;
        if (jt < 24) d.c0 = 64 * jt; else if (jt < 56) { d.c0 = 1600 + 64 * (jt - 24); d.colscale = SWA_QSCALE; } else if (jt < 64) d.c0 = 3648 + 64 * (jt - 56); else { d.c0 = 1536; d.perm = 1; }
    } else if ((it -= IT_IN) < IT_QUP) { const int jt = it % 48; kt = it / 48; d.src = P.w_qup; d.N = 3072; d.dst = (bf16_t*)(ws + WS_WQUP); d.ldk = 1024; d.n0 = jt * 64; d.rowscale = P.g_qa;
        if (jt < 32) d.c0 = (jt >> 1) * 192 + 64 * (jt & 1); else { d.c0 = (jt - 32) * 192 + 128; d.perm = 1; }
    } else if ((it -= IT_QUP) < IT_KVUP) { const int jt = it % 64; kt = it / 64; d.src = P.w_kvup; d.N = 4096; d.dst = (bf16_t*)(ws + WS_WKVUP); d.ldk = 512; d.n0 = jt * 64; d.rowscale = P.g_kva;
        if (jt < 32) d.c0 = (jt >> 1) * 256 + 64 * (jt & 1); else d.c0 = ((jt - 32) >> 1) * 256 + 128 + 64 * (jt & 1);
    } else if ((it -= IT_KVUP) < IT_O) { const int jt = it % 64; kt = it / 64; d.src = P.w_o; d.N = D; d.dst = (bf16_t*)(ws + WS_WO); d.ldk = D; d.n0 = jt * 64; d.c0 = jt * 64; d.rowscale = P.g_mla; d.rowscale_hi = P.g_swa;
    } else if ((it -= IT_O) < IT_GU) { const int jt = it % 344; kt = it / 344; const int t = jt >> 2, sub = jt & 3; d.src = sub < 2 ? P.w_gate : P.w_up; d.N = DFF; d.dst = (bf16_t*)(ws + WS_WGU); d.ldk = D; d.n0 = jt * 64;
        d.c0 = 128 * t + 64 * (sub & 1);
    } else if ((it -= IT_GU) < IT_DN) { const int jt = it % 64; kt = it / 64; d.src = P.w_down; d.N = D; d.dst = (bf16_t*)(ws + WS_WDN); d.ldk = DFF; d.n0 = jt * 64; d.c0 = jt * 64;
    } else if ((it -= IT_DN) < IT_PG) { const int jt = it % 64; kt = it / 64; d.src = P.w_pg; d.N = D; d.dst = (bf16_t*)(ws + WS_WPG); d.ldk = D; d.n0 = jt * 64; d.c0 = jt * 64;
    } else { it -= IT_PG; const int jt = it % 64; kt = it / 64; d.src = P.w_pp; d.N = D; d.dst = (bf16_t*)(ws + WS_WPP); d.ldk = PLE; d.n0 = jt * 64; d.c0 = jt * 64; }
    transpose_item(d, kt, scr, lane);
}

DI void sincos_d(double a, float& c, float& s) {
    const double n = __builtin_rint(a * 0.15915494309189535);
    double r = __builtin_fma(-n, 6.283185307179586, a);
    r = __builtin_fma(-n, 2.4492935982947064e-16, r);
    double sg = 1.0;
    if (r > 1.5707963267948966) { r = 3.141592653589793 - r; sg = -1.0; }
    else if (r < -1.5707963267948966) { r = -3.141592653589793 - r; sg = -1.0; }
    const double r2 = r * r;
    double ps = -1.0 / 1307674368000.0;
    ps = ps * r2 + 1.0 / 6227020800.0; ps = ps * r2 - 1.0 / 39916800.0; ps = ps * r2 + 1.0 / 362880.0; ps = ps * r2 - 1.0 / 5040.0;
    ps = ps * r2 + 1.0 / 120.0; ps = ps * r2 - 1.0 / 6.0; ps = ps * r2 + 1.0;
    double pc = 1.0 / 20922789888000.0;
    pc = pc * r2 - 1.0 / 87178291200.0; pc = pc * r2 + 1.0 / 479001600.0; pc = pc * r2 - 1.0 / 3628800.0; pc = pc * r2 + 1.0 / 40320.0;
    pc = pc * r2 - 1.0 / 720.0; pc = pc * r2 + 1.0 / 24.0; pc = pc * r2 - 0.5; pc = pc * r2 + 1.0;
    s = (float)(ps * r); c = (float)(sg * pc);
}

DI void phase0(const Ptrs& P, LAS unsigned char* lds) {
    const int tid = my_tid(), lane = tid & 63, wave = tid >> 6;
    const int gw = blockIdx.x * 8 + wave, NGW = gridDim.x * 8;
    const int gt = blockIdx.x * 512 + tid, NGT = gridDim.x * 512;
    unsigned char* ws = P.ws;
    { float* sq = (float*)(ws + WS_SSQ); for (int i = gt; i < 6 * T; i += NGT) sq[i] = 0.f; }
    { f32x2* cs = (f32x2*)(ws + WS_CS);
      for (int i = gt; i < T * 32; i += NGT) { const int t = i >> 5, f = i & 31; double fr = 1.0; for (int k = 0; k < f; ++k) fr *= 0.7498942093324559;
          float c, s; sincos_d((double)P.pos[t] * fr, c, s); cs[i] = (f32x2){c, s}; } }
    { bf16_t* pb = (bf16_t*)(ws + WS_PB);
      for (int i = gt; i < T * PLE / 8; i += NGT) { const f32x4 a = *(const f32x4*)(P.p + (size_t)i * 8), b = *(const f32x4*)(P.p + (size_t)i * 8 + 4); *(u32x4*)(pb + (size_t)i * 8) = pack8(a, b); } }
    { bf16_t* h = (bf16_t*)(ws + WS_R0);
      for (int row = gw; row < T; row += NGW) {
          const f32x4* xr = (const f32x4*)(P.x + (size_t)row * D) + lane;
          f32x4 v[16]; float s = 0.f;
#pragma unroll
          for (int j = 0; j < 16; ++j) { v[j] = xr[64 * j]; s += (v[j][0] * v[j][0] + v[j][1] * v[j][1]) + (v[j][2] * v[j][2] + v[j][3] * v[j][3]); }
          const float rs = rsqrtf(wave_sum(s) * (1.0f / D) + EPS);
          u32x2* o = (u32x2*)(h + (size_t)row * D) + lane;
          const f32x4* gr = (const f32x4*)P.g_attn_pre + lane;
          f32x4 gv[16];
#pragma unroll
          for (int j = 0; j < 16; ++j) gv[j] = gr[64 * j];
#pragma unroll
          for (int j = 0; j < 16; ++j) { const f32x4 g = gv[j]; u32x2 w; w.x = pk2(v[j][0] * rs * g[0], v[j][1] * rs * g[1]); w.y = pk2(v[j][2] * rs * g[2], v[j][3] * rs * g[3]); o[64 * j] = w; }
      } }
    { LAS float* scr = (LAS float*)(lds + wave * 16640);
      for (int it = gw; it < IT_TOTAL; it += NGW) conv_item(P, it, scr, lane); }
}

DI void kr_phase(const Ptrs& P) {
    unsigned char* ws = P.ws; const float* krp = (const float*)(ws + WS_KRP); const f32x2* cs = (const f32x2*)(ws + WS_CS); bf16_t* k192 = (bf16_t*)(ws + WS_KN);
    const int tid = my_tid(), gt = blockIdx.x * 512 + tid, NGT = gridDim.x * 512;
    for (int idx = gt; idx < T * 8; idx += NGT) {
        const int row = idx >> 3, c0 = (idx & 7) * 8;
        f32x4 v0 = {0.f, 0.f, 0.f, 0.f}, v1 = {0.f, 0.f, 0.f, 0.f};
#pragma unroll
        for (int kq = 0; kq < 4; ++kq) { const float* p = krp + ((size_t)kq * T + row) * 64 + c0; v0 += *(const f32x4*)p; v1 += *(const f32x4*)(p + 4); }
        rope8(v0, v1, cs + (size_t)row * 32 + (c0 >> 1));
        const u32x4 pv = pack8(v0, v1);
        bf16_t* kp = k192 + (size_t)row * 3072 + 128 + c0;
#pragma unroll
        for (int hd = 0; hd < 16; ++hd) *(u32x4*)(kp + hd * 192) = pv;
    }
}

#define MFMA32(a, b, c) __builtin_amdgcn_mfma_f32_32x32x16_bf16((a), (b), (c), 0, 0, 0)
DI bf16x8 packp(const f32x16& x, int s) {
    u32x4 p; p.x = pk2(x[8 * s], x[8 * s + 1]); p.y = pk2(x[8 * s + 2], x[8 * s + 3]); p.z = pk2(x[8 * s + 4], x[8 * s + 5]); p.w = pk2(x[8 * s + 6], x[8 * s + 7]);
    return __builtin_bit_cast(bf16x8, p);
}
DI f32x16 zero16() { f32x16 z;
#pragma unroll
    for (int i = 0; i < 16; ++i) z[i] = 0.f;
    return z; }

DI void mla_phase(const Ptrs& P, LAS unsigned char* lds, float* ssqbase) {
    unsigned char* ws = P.ws;
    const bf16_t* q = (const bf16_t*)(ws + WS_Q); const unsigned char* k192 = ws + WS_KN;
    const unsigned char* vt = ws + WS_VT; bf16_t* mixed = (bf16_t*)(ws + WS_R0); float* ssqA = ssqbase + 2 * T;
    const int tid = my_tid(), lane = tid & 63, w = __builtin_amdgcn_readfirstlane(tid >> 6), qi = lane & 31, g = lane >> 5;
    constexpr int KBYTES = 64 * 384, BUF = KBYTES + 128 * 128;
    const float NINF = -__builtin_inff();
    unsigned koff[3], voff[2];
#pragma unroll
    for (int i = 0; i < 3; ++i) { const int u = 64 * (w * 3 + i) + lane, row = u / 24, pos = u % 24, ch = (pos & ~7) | ((pos & 7) ^ ((row >> 1) & 7)); koff[i] = (unsigned)(row * 6144 + ch * 16); }
#pragma unroll
    for (int i = 0; i < 2; ++i) { const int u = 64 * (w * 2 + i) + lane, d = u >> 3, pos = u & 7, ch = pos ^ ((d >> 1) & 7); voff[i] = (unsigned)(d * (VPITCH * 2) + ch * 16); }
    int kaddr[4], vaddr[4];
    { const int pr = pi32(qi), swk = (pr >> 1) & 7, swv = (qi >> 1) & 7;
#pragma unroll
      for (int j = 0; j < 4; ++j) { kaddr[j] = pr * 384 + 16 * ((2 * j + g) ^ swk); vaddr[j] = KBYTES + qi * 128 + 16 * ((2 * j + g) ^ swv); } }
    const unsigned ldsbase = (unsigned)(size_t)lds;
#define MLA_DMA(kt, bufoff) do { const unsigned char* _kb = uni_ptr(kbase + (size_t)(kt) * (64 * 6144)); const unsigned char* _vb = uni_ptr(vbase + (size_t)(kt) * 128); const unsigned _l = ldsbase + (unsigned)(bufoff); \
        _Pragma("unroll") for (int _i = 0; _i < 3; ++_i) dma16(_kb, koff[_i], _l + (unsigned)((w * 3 + _i) * 1024)); \
        _Pragma("unroll") for (int _i = 0; _i < 2; ++_i) dma16(_vb, voff[_i], _l + (unsigned)(KBYTES + (w * 2 + _i) * 1024)); } while (0)
    for (int uu0 = blockIdx.x; uu0 < 1024 * (PROBE_PH == 31 ? PROBE_N : 1); uu0 += gridDim.x) {
        const int uu = uu0 & 1023;
        const int kk = uu >> 8, c = uu & 255, bh = c & 31, jj = c >> 5;
        const int qb = kk == 0 ? 31 - jj : kk == 1 ? 16 + jj : kk == 2 ? 15 - jj : jj;
        const int b = bh >> 4, h = bh & 15;
        const int r0 = qb * 256 + w * 32;
        const unsigned char* kbase = k192 + ((size_t)(b * S) * 16 + h) * 384;
        const unsigned char* vbase = vt + (size_t)(bh * 128) * (VPITCH * 2);
        const int nkt = 4 * (qb + 1);
        MLA_DMA(0, 0); MLA_DMA(1, BUF);
        bf16x8 qf[12];
        { const bf16_t* qrow = q + (size_t)(b * S + r0 + qi) * QW;
#pragma unroll
          for (int ks = 0; ks < 8; ++ks) qf[ks] = *(const bf16x8*)(qrow + h * 128 + ks * 16 + g * 8);
#pragma unroll
          for (int ks = 0; ks < 4; ++ks) qf[8 + ks] = *(const bf16x8*)(qrow + 2048 + h * 64 + ks * 16 + g * 8); }
        f32x16 oacc[4];
#pragma unroll
        for (int i = 0; i < 4; ++i) oacc[i] = zero16();
        float m_run = NINF, l_run = 0.f;
#pragma unroll
        for (int ks = 0; ks < 12; ++ks) asm volatile("" :: "v"(qf[ks]));
        asm volatile("s_waitcnt vmcnt(0)" ::: "memory"); __syncthreads();
#define MLA_QK(KA, IMM, sacc_) do { \
        bf16x8 fa[4], fb[4]; \
        _Pragma("unroll") for (int j = 0; j < 4; ++j) fa[j] = *(const LAS bf16x8*)(lds + KA[j] + (IMM)); \
        _Pragma("unroll") for (int j = 0; j < 4; ++j) fb[j] = *(const LAS bf16x8*)(lds + KA[j] + (IMM) + 128); \
        __builtin_amdgcn_sched_barrier(0); \
        __builtin_amdgcn_s_setprio(1); \
        _Pragma("unroll") for (int gi = 0; gi < 6; gi += 2) { \
            _Pragma("unroll") for (int j = 0; j < 4; ++j) sacc_[gi / 3] = MFMA32(fa[j], qf[4 * (gi % 3) + j], sacc_[gi / 3]); \
            if (gi + 2 < 6) { _Pragma("unroll") for (int j = 0; j < 4; ++j) fa[j] = *(const LAS bf16x8*)(lds + KA[j] + (IMM) + 128 * ((gi + 2) % 3) + 12288 * ((gi + 2) / 3)); } \
            __builtin_amdgcn_sched_barrier(0); \
            _Pragma("unroll") for (int j = 0; j < 4; ++j) sacc_[(gi + 1) / 3] = MFMA32(fb[j], qf[4 * ((gi + 1) % 3) + j], sacc_[(gi + 1) / 3]); \
            if (gi + 3 < 6) { _Pragma("unroll") for (int j = 0; j < 4; ++j) fb[j] = *(const LAS bf16x8*)(lds + KA[j] + (IMM) + 128 * ((gi + 3) % 3) + 12288 * ((gi + 3) / 3)); } \
            __builtin_amdgcn_sched_barrier(0); \
        } \
        __builtin_amdgcn_s_setprio(0); } while (0)
#define MLA_SMPV(VA, IMM, sacc_, kt_) do { \
        if (64 * (kt_) + 63 > r0) { \
            const int qrow = r0 + qi; \
            _Pragma("unroll") for (int kb = 0; kb < 2; ++kb) \
            _Pragma("unroll") for (int e = 0; e < 16; ++e) { const int key = 64 * (kt_) + kb * 32 + 16 * (e >> 3) + 8 * g + (e & 7); if (key > qrow) sacc_[kb][e] = NINF; } \
        } \
        float mx = NINF; \
        _Pragma("unroll") for (int kb = 0; kb < 2; ++kb) \
        _Pragma("unroll") for (int e = 0; e < 16; ++e) mx = fmaxf(mx, sacc_[kb][e]); \
        mx = xhalf_max(mx); \
          \
          \
        float alpha = 1.0f; \
        if (__builtin_amdgcn_ballot_w64((mx - m_run) > 8.0f) != 0ull) { \
            const float m_new = fmaxf(m_run, mx); \
            alpha = fast_exp2(m_run - m_new); \
            m_run = m_new; \
            _Pragma("unroll") for (int db = 0; db < 4; ++db) \
            _Pragma("unroll") for (int e = 0; e < 16; ++e) oacc[db][e] *= alpha; \
        } \
        float lsum = 0.f; \
        _Pragma("unroll") for (int kb = 0; kb < 2; ++kb) \
        _Pragma("unroll") for (int e = 0; e < 16; ++e) { const float p = fast_exp2(sacc_[kb][e] - m_run); sacc_[kb][e] = p; lsum += p; } \
        l_run = l_run * alpha + lsum; \
        _Pragma("unroll") for (int kb = 0; kb < 2; ++kb) \
        _Pragma("unroll") for (int s2 = 0; s2 < 2; ++s2) { \
            const bf16x8 pf = packp(sacc_[kb], s2); \
            _Pragma("unroll") for (int db = 0; db < 4; ++db) oacc[db] = MFMA32(*(const LAS bf16x8*)(lds + VA[kb * 2 + s2] + (IMM) + 4096 * db), pf, oacc[db]); \
        } } while (0)
#define MLA_INTERVAL(KA, VA, kp_, NB) do { \
        { f32x16 sacc[2]; sacc[0] = zero16(); sacc[1] = zero16(); \
          if (64 * (kp_) <= r0) { MLA_QK(KA, 0, sacc); MLA_SMPV(VA, 0, sacc, (kp_)); } } \
        if ((kp_) + 2 < nkt) { MLA_DMA((kp_) + 2, (NB)); MLA_DMA((kp_) + 3, (NB) + BUF); } \
        { f32x16 sacc[2]; sacc[0] = zero16(); sacc[1] = zero16(); \
          if (64 * ((kp_) + 1) <= r0) { MLA_QK(KA, BUF, sacc); MLA_SMPV(VA, BUF, sacc, (kp_) + 1); } } \
        asm volatile("s_waitcnt vmcnt(0)" ::: "memory"); __syncthreads(); } while (0)
        int kaddrH[4], vaddrH[4];
#pragma unroll
        for (int j = 0; j < 4; ++j) { kaddrH[j] = kaddr[j] + 2 * BUF; vaddrH[j] = vaddr[j] + 2 * BUF; }
#pragma unroll 1
        for (int kp = 0; kp < nkt; kp += 4) {
            MLA_INTERVAL(kaddr, vaddr, kp, 2 * BUF);
            MLA_INTERVAL(kaddrH, vaddrH, kp + 2, 0);
        }
#undef MLA_QK
#undef MLA_SMPV
#undef MLA_INTERVAL
        const float l = l_run + __shfl_xor(l_run, 32);
        const float inv = 1.0f / l;
        float sq = 0.f;
        bf16_t* orow = mixed + (size_t)(b * S + r0 + qi) * D + h * 128 + 8 * g;
#pragma unroll
        for (int db = 0; db < 4; ++db)
#pragma unroll
            for (int t2 = 0; t2 < 2; ++t2) {
                unsigned wa[2], wb[2];
#pragma unroll
                for (int q2 = 0; q2 < 2; ++q2) {
                    const int j4 = 2 * t2 + q2;
                    const float o0 = oacc[db][4 * j4] * inv, o1 = oacc[db][4 * j4 + 1] * inv, o2 = oacc[db][4 * j4 + 2] * inv, o3 = oacc[db][4 * j4 + 3] * inv;
                    sq += (o0 * o0 + o1 * o1) + (o2 * o2 + o3 * o3);
                    if (q2 == 0) { wa[0] = pk2(o0, o1); wa[1] = pk2(o2, o3); } else { wb[0] = pk2(o0, o1); wb[1] = pk2(o2, o3); }
                }
                const auto rx = __builtin_amdgcn_permlane32_swap(wa[0], wb[0], false, false);
                const auto ry = __builtin_amdgcn_permlane32_swap(wa[1], wb[1], false, false);
                u32x4 wv; wv.x = rx[0]; wv.y = ry[0]; wv.z = rx[1]; wv.w = ry[1];
                *(u32x4*)(orow + 32 * db + 16 * t2) = wv;
            }
        sq += __shfl_xor(sq, 32);
        if (g == 0) unsafeAtomicAdd(ssqA + (uu0 >= 1024 ? 6 * T : 0) + b * S + r0 + qi, sq);
    }
#undef MLA_DMA
}

DI void swa_phase(const Ptrs& P, LAS unsigned char* lds, float* ssqbase) {
    unsigned char* ws = P.ws;
    const bf16_t* proj = (const bf16_t*)(ws + WS_PROJ); const bf16_t* vts = (const bf16_t*)(ws + WS_VTS);
    bf16_t* mixed = (bf16_t*)(ws + WS_R0); float* ssqB = ssqbase + 3 * T;
    const int tid = my_tid(), lane = tid & 63, w = __builtin_amdgcn_readfirstlane(tid >> 6), qi = lane & 31, g = lane >> 5;
    constexpr int KST = 144, VST = 528, KBYTES = 256 * KST, VBYTES = 64 * VST;
    LAS float* POS = (LAS float*)(lds + KBYTES + VBYTES);
    const float NINF = -__builtin_inff();
    for (int uu0 = blockIdx.x; uu0 < 2048 * (PROBE_PH == 32 ? PROBE_N : 1); uu0 += gridDim.x) {
        const int uu = uu0 & 2047;
        const int hp = uu & 3, gk = (uu >> 2) & 3, n = (uu >> 4) & 63, b = uu >> 10;
        const int key_base = (n - 1) * 128;
        __syncthreads();
#pragma unroll
        for (int i = 0; i < 4; ++i) {
            const int id = tid + 512 * i;
            { const int kl = id >> 3, ch = id & 7, key = key_base + kl, keyc = key < 0 ? 0 : key;
              u32x4 v = *(const u32x4*)(proj + (size_t)(b * S + keyc) * DIN_P + PJ_KS + gk * 64 + ch * 8);
              if (key < 0) v = (u32x4){0u, 0u, 0u, 0u};
              *(LAS u32x4*)(lds + kl * KST + ch * 16) = v; }
            { const int d = id >> 5, ch = id & 31, key = key_base + ch * 8, keyc = key < 0 ? 0 : key;
              u32x4 v = *(const u32x4*)(vts + (size_t)((b * 4 + gk) * 64 + d) * VPITCH + keyc);
              if (key < 0) v = (u32x4){0u, 0u, 0u, 0u};
              *(LAS u32x4*)(lds + KBYTES + d * VST + ch * 16) = v; }
        }
        if (tid < 256) { const int key = key_base + tid, keyc = key < 0 ? 0 : key; const float pv = (float)P.pos[b * S + keyc]; POS[tid] = key >= 0 ? pv : 0.f; }
        __syncthreads();
        const int head = gk * 8 + hp * 2 + (w >> 2), wq = w & 3, qoff = wq * 32;
        const int trow = b * S + n * 128 + qoff + qi;
        bf16x8 qf[4];
#pragma unroll
        for (int ks = 0; ks < 4; ++ks) qf[ks] = *(const bf16x8*)(proj + (size_t)trow * DIN_P + PJ_QS + head * 64 + ks * 16 + g * 8);
        const float posq = (float)P.pos[trow];
        const float slope2 = fast_exp2(-0.25f * (float)(head + 1)) * LOG2E;
        const float sink2 = P.sinks[head] * LOG2E;
        f32x16 sacc[5];
#pragma unroll
        for (int t = 0; t < 5; ++t) {
            const int kb = wq + t;
            const LAS unsigned char* kp = lds + (kb * 32 + pi32(qi)) * KST + g * 16;
            f32x16 a = zero16();
#pragma unroll
            for (int ks = 0; ks < 4; ++ks) a = MFMA32(*(const LAS bf16x8*)(kp + ks * 32), qf[ks], a);
            sacc[t] = a;
            __builtin_amdgcn_sched_barrier(0);
        }
        float mx = sink2;
#pragma unroll
        for (int t = 0; t < 5; ++t) {
            const int kb = wq + t;
            const bool padblk = (n == 0) && (kb < 4);
#pragma unroll
            for (int hh = 0; hh < 2; ++hh) {
                const int kl0 = kb * 32 + 16 * hh + 8 * g;
                const f32x4 pa = *(const LAS f32x4*)(POS + kl0), pb = *(const LAS f32x4*)(POS + kl0 + 4);
#pragma unroll
                for (int e = 0; e < 8; ++e) {
                    const int kll = 16 * hh + 8 * g + e;
                    const float pk = e < 4 ? pa[e & 3] : pb[e & 3];
                    float sv = sacc[t][8 * hh + e] - slope2 * fabsf(posq - pk);
                    bool valid = !padblk;
                    if (t == 0) valid = valid && (kll > qi);
                    if (t == 4) valid = valid && (kll <= qi);
                    sv = valid ? sv : NINF;
                    sacc[t][8 * hh + e] = sv; mx = fmaxf(mx, sv);
                }
            }
        }
        mx = xhalf_max(mx);
        float lsum = 0.f;
#pragma unroll
        for (int t = 0; t < 5; ++t)
#pragma unroll
            for (int e = 0; e < 16; ++e) { const float p = fast_exp2(sacc[t][e] - mx); sacc[t][e] = p; lsum += p; }
        f32x16 oacc[2]; oacc[0] = zero16(); oacc[1] = zero16();
#pragma unroll
        for (int t = 0; t < 5; ++t) {
            const int kb = wq + t;
#pragma unroll
            for (int s2 = 0; s2 < 2; ++s2) {
                const bf16x8 pf = packp(sacc[t], s2);
#pragma unroll
                for (int db = 0; db < 2; ++db) {
                    const LAS unsigned char* vp = lds + KBYTES + (32 * db + qi) * VST + (kb * 32 + 16 * s2 + 8 * g) * 2;
                    oacc[db] = MFMA32(*(const LAS bf16x8*)vp, pf, oacc[db]);
                }
                __builtin_amdgcn_sched_barrier(0);
            }
        }
        const float l = lsum + __shfl_xor(lsum, 32) + fast_exp2(sink2 - mx);
        const float inv = 1.0f / l;
        float sq = 0.f;
        bf16_t* orow = mixed + (size_t)trow * D + 2048 + head * 64 + 4 * g;
#pragma unroll
        for (int db = 0; db < 2; ++db)
#pragma unroll
            for (int j4 = 0; j4 < 4; ++j4) {
                const float o0 = oacc[db][4 * j4] * inv, o1 = oacc[db][4 * j4 + 1] * inv, o2 = oacc[db][4 * j4 + 2] * inv, o3 = oacc[db][4 * j4 + 3] * inv;
                sq += (o0 * o0 + o1 * o1) + (o2 * o2 + o3 * o3);
                u32x2 wv; wv.x = pk2(o0, o1); wv.y = pk2(o2, o3);
                *(u32x2*)(orow + 32 * db + 8 * j4) = wv;
            }
        sq += __shfl_xor(sq, 32);
        if (g == 0) unsafeAtomicAdd(ssqB + (uu0 >= 2048 ? 6 * T : 0) + trow, sq);
    }
}

DI void norm_mixed_phase(const Ptrs& P) {
    unsigned char* ws = P.ws; bf16_t* mixed = (bf16_t*)(ws + WS_R0);
    const float* ssqA = (const float*)(ws + WS_SSQ) + 2 * T; const float* ssqB = ssqA + T;
    const int tid = my_tid(), lane = tid & 63, gw = blockIdx.x * 8 + (tid >> 6), NGW = gridDim.x * 8;
    for (int row = gw; row < T; row += NGW) {
        const float rsA = rsqrtf(ssqA[row] * (1.0f / 2048.0f) + EPS), rsB = rsqrtf(ssqB[row] * (1.0f / 2048.0f) + EPS);
        u32x4* mp = (u32x4*)(mixed + (size_t)row * D) + lane;
#pragma unroll
        for (int j = 0; j < 8; ++j) {
            const int col0 = (lane + 64 * j) * 8; const bool hb = col0 >= 2048;
            const float rs = hb ? rsB : rsA; const float* gp = hb ? P.g_swa + (col0 - 2048) : P.g_mla + col0;
            const f32x4 g0 = *(const f32x4*)gp, g1 = *(const f32x4*)(gp + 4);
            const u32x4 v = mp[64 * j]; u32x4 o;
            o.x = pk2(bflo(v.x) * rs * g0[0], bfhi(v.x) * rs * g0[1]); o.y = pk2(bflo(v.y) * rs * g0[2], bfhi(v.y) * rs * g0[3]);
            o.z = pk2(bflo(v.z) * rs * g1[0], bfhi(v.z) * rs * g1[1]); o.w = pk2(bflo(v.w) * rs * g1[2], bfhi(v.w) * rs * g1[3]);
            mp[64 * j] = o;
        }
    }
}
DI void x1_phase(const Ptrs& P) {
    unsigned char* ws = P.ws; const bf16_t* y = (const bf16_t*)(ws + WS_Y); const float* ssq_y = (const float*)(ws + WS_SSQ) + 4 * T; bf16_t* h2 = (bf16_t*)(ws + WS_R0);
    const int tid = my_tid(), lane = tid & 63, gw = blockIdx.x * 8 + (tid >> 6), NGW = gridDim.x * 8;
    for (int row = gw; row < T; row += NGW) {
        const float rsy = rsqrtf(ssq_y[row] * (1.0f / D) + EPS);
        const f32x4* xr = (const f32x4*)(P.x + (size_t)row * D) + lane; const u32x2* yr = (const u32x2*)(y + (size_t)row * D) + lane;
        const f32x4* gp = (const f32x4*)P.g_attn_post + lane; u32x2* op = (u32x2*)((bf16_t*)P.out + (size_t)row * D) + lane;
        f32x4 v[16]; float s = 0.f;
#pragma unroll
        for (int hb = 0; hb < 2; ++hb) {
            f32x4 a[8], gg[8]; u32x2 yb[8];
#pragma unroll
            for (int j = 0; j < 8; ++j) { a[j] = xr[64 * (8 * hb + j)]; gg[j] = gp[64 * (8 * hb + j)]; yb[j] = yr[64 * (8 * hb + j)]; }
#pragma unroll
            for (int j = 0; j < 8; ++j) { const f32x4 bq = {bflo(yb[j].x), bfhi(yb[j].x), bflo(yb[j].y), bfhi(yb[j].y)};
                const f32x4 r = a[j] + bq * rsy * gg[j]; v[8 * hb + j] = r; u32x2 xb; xb.x = pk2(r[0], r[1]); xb.y = pk2(r[2], r[3]); op[64 * (8 * hb + j)] = xb;
                s += (r[0] * r[0] + r[1] * r[1]) + (r[2] * r[2] + r[3] * r[3]); }
        }
        const f32x4* g2 = (const f32x4*)P.g_ffn_pre + lane;
        f32x4 g2v[16];
#pragma unroll
        for (int j = 0; j < 16; ++j) g2v[j] = g2[64 * j];
        const float rs = rsqrtf(wave_sum(s) * (1.0f / D) + EPS);
        u32x2* o = (u32x2*)(h2 + (size_t)row * D) + lane;
#pragma unroll
        for (int j = 0; j < 16; ++j) { const f32x4 gg = g2v[j]; u32x2 wv; wv.x = pk2(v[j][0] * rs * gg[0], v[j][1] * rs * gg[1]); wv.y = pk2(v[j][2] * rs * gg[2], v[j][3] * rs * gg[3]); o[64 * j] = wv; }
    }
}
DI void x2_phase(const Ptrs& P) {
    unsigned char* ws = P.ws; const bf16_t* f = (const bf16_t*)(ws + WS_F); const float* ssq_f = (const float*)(ws + WS_SSQ) + 5 * T; bf16_t* x2b = (bf16_t*)(ws + WS_X2B);
    const int tid = my_tid(), lane = tid & 63, gw = blockIdx.x * 8 + (tid >> 6), NGW = gridDim.x * 8;
    for (int row = gw; row < T; row += NGW) {
        const float rsf = rsqrtf(ssq_f[row] * (1.0f / D) + EPS);
        const u32x2* fr = (const u32x2*)(f + (size_t)row * D) + lane; const f32x4* gp = (const f32x4*)P.g_ffn_post + lane;
        const u32x2* op = (const u32x2*)((const bf16_t*)P.out + (size_t)row * D) + lane; u32x2* o = (u32x2*)(x2b + (size_t)row * D) + lane;
        u32x2 abv[16], fbv[16]; f32x4 ggv[16];
#pragma unroll
        for (int j = 0; j < 16; ++j) { abv[j] = op[64 * j]; fbv[j] = fr[64 * j]; ggv[j] = gp[64 * j]; }
#pragma unroll
        for (int j = 0; j < 16; ++j) { const u32x2 ab = abv[j]; const f32x4 a = {bflo(ab.x), bfhi(ab.x), bflo(ab.y), bfhi(ab.y)}, gg = ggv[j]; const u32x2 fb = fbv[j]; const f32x4 bq = {bflo(fb.x), bfhi(fb.x), bflo(fb.y), bfhi(fb.y)};
            const f32x4 r = a + bq * rsf * gg;
            u32x2 wv; wv.x = pk2(r[0], r[1]); wv.y = pk2(r[2], r[3]); o[64 * j] = wv; }
    }
}

constexpr int NPHASE = 11;
struct Params { const void* in[21]; float* out; unsigned char* ws; int ph_lo, ph_hi; };

__global__ void __launch_bounds__(512, 2) mk_fwd(Params prm) {
    extern __shared__ __attribute__((aligned(16))) unsigned char lds_raw[];
    LAS unsigned char* lds = (LAS unsigned char*)lds_raw;
#define GPTR(T, i) ((T*)(T __attribute__((address_space(1)))*)kin[i])
#define LOADP() Ptrs P; { const void* kin[23]; _Pragma("unroll") for (int _q = 0; _q < 21; ++_q) kin[_q] = prm.in[_q]; kin[21] = prm.out; kin[22] = prm.ws; \
    P.x = GPTR(const float, 0); P.p = GPTR(const float, 1); P.pos = GPTR(const int, 2); P.g_attn_pre = GPTR(const float, 3); P.w_in = GPTR(const float, 4); \
    P.g_qa = GPTR(const float, 5); P.w_qup = GPTR(const float, 6); P.g_kva = GPTR(const float, 7); P.w_kvup = GPTR(const float, 8); P.sinks = GPTR(const float, 9); \
    P.g_mla = GPTR(const float, 10); P.g_swa = GPTR(const float, 11); P.w_o = GPTR(const float, 12); P.g_attn_post = GPTR(const float, 13); P.g_ffn_pre = GPTR(const float, 14); \
    P.w_gate = GPTR(const float, 15); P.w_up = GPTR(const float, 16); P.w_down = GPTR(const float, 17); P.g_ffn_post = GPTR(const float, 18); \
    P.w_pg = GPTR(const float, 19); P.w_pp = GPTR(const float, 20); P.out = GPTR(float, 21); P.ws = GPTR(unsigned char, 22); \
 } \
    unsigned char* ws = P.ws; float* ssq = (float*)(ws + WS_SSQ); const f32x2* cs = (const f32x2*)(ws + WS_CS); (void)ssq; (void)cs;
    const int lo = prm.ph_lo, hi = prm.ph_hi;
    const int G = gridDim.x, cid = blockIdx.x;
    if (hi - lo > 1) xcd_barrier_post((unsigned*)(prm.ws + WS_KR));
    if (hi > 1000) cg::this_grid().sync();
#define IN(k) (lo <= (k) && (k) < hi)
#define SEAM(k) do { if (IN((k) + 1)) xcd_barrier((unsigned*)(ws + WS_KR)); } while (0)
#define NREP(k) ((PROBE_PH == (k) || (PROBE_PH >= 10 && PROBE_PH / 10 == (k))) ? PROBE_N : 1)
#define REPSYNC(k) do { if (_r + 1 < NREP(k)) cg::this_grid().sync(); } while (0)
    if (IN(0)) { LOADP(); phase0(P, lds); if (PROBE_PH == 0) { cg::this_grid().sync(); phase0(P, lds); } SEAM(0); }
    if (IN(1)) { LOADP();
        for (int _r = 0; _r < NREP(1); ++_r) {
        float* sq = ssq + (_r ? 6 * T : 0);
        { pg8::Gemm g{(const bf16_t*)(ws + WS_R0), (const bf16_t*)(ws + WS_WIN), T, 3840, D, D, D}; pg8::StaticOrder So; So.init(T, 3840, G, cid);
          EpiIn E{(bf16_t*)(ws + WS_PROJ), sq, sq + T, (bf16_t*)(ws + WS_VTS), (bf16_t*)(ws + WS_KN), cs};
          pg8::gemm_phase<EpiIn>(lds, g, So, E); }
        {
            const int t0 = (64 * 15) % G, gp = t0 ? G - t0 : G, cp = t0 ? cid - t0 : cid;
            if (cp >= 0) {
                pg8::Gemm g{(const bf16_t*)(ws + WS_WIN) + (size_t)3840 * D, (const bf16_t*)(ws + WS_R0), 256, T, D, D, D}; pg8::StaticOrder So; So.init(256, T, gp, cp);
                EpiVt E{(bf16_t*)(ws + WS_VTS), 256, nullptr, 0.f};
                pg8::gemm_phase<EpiVt>(lds, g, So, E);
            }
        }
        { pg8::Gemm g{(const bf16_t*)(ws + WS_R0), (const bf16_t*)(ws + WS_WIN) + (size_t)4096 * D, T, 256, 1024, D, D}; pg8::StaticOrder So; So.init(T, 256, G, cid, 2);
          EpiKr E{(float*)(ws + WS_KRP)};
          pg8::gemm_phase<EpiKr>(lds, g, So, E); }
        REPSYNC(1); }
        SEAM(1);
    }
    if (IN(2)) { LOADP();
        kr_phase(P);
        for (int _r = 0; _r < NREP(2); ++_r) {
        { pg8::Gemm g{(const bf16_t*)(ws + WS_PROJ) + PJ_CQ, (const bf16_t*)(ws + WS_WQUP), T, QW, 1024, DIN_P, 1024}; pg8::StaticOrder So; So.init(T, QW, G, cid);
          EpiUp<0> E{ssq, 1.0f / 1024.0f, MLA_QSCALE, (bf16_t*)(ws + WS_Q), QW, cs, nullptr};
          pg8::gemm_phase<EpiUp<0>>(lds, g, So, E); }
        { pg8::Gemm g{(const bf16_t*)(ws + WS_PROJ) + PJ_CKV, (const bf16_t*)(ws + WS_WKVUP), T, 2048, 512, DIN_P, 512}; pg8::StaticOrder So; So.init(T, 2048, G, cid);
          EpiUp<1> E{ssq + T, 1.0f / 512.0f, 1.0f, (bf16_t*)(ws + WS_KN), KNW, cs, nullptr};
          pg8::gemm_phase<EpiUp<1>>(lds, g, So, E); }
        { pg8::Gemm g{(const bf16_t*)(ws + WS_WKVUP) + (size_t)2048 * 512, (const bf16_t*)(ws + WS_PROJ) + PJ_CKV, 2048, T, 512, 512, DIN_P}; pg8::StaticOrder So; So.init(2048, T, G, cid);
          EpiVt E{(bf16_t*)(ws + WS_VT), 2048, ssq + T, 1.0f / 512.0f};
          pg8::gemm_phase<EpiVt>(lds, g, So, E); }
        REPSYNC(2); }
        SEAM(2);
    }
    if (IN(3)) { LOADP();
        mla_phase(P, lds, ssq); swa_phase(P, lds, ssq);
        SEAM(3);
    }
    if (IN(5)) { LOADP();
        for (int _r = 0; _r < NREP(5); ++_r) {
        pg8::Gemm g{(const bf16_t*)(ws + WS_R0), (const bf16_t*)(ws + WS_WO), T, D, 2048, D, D}; pg8::StaticOrder So; So.init(T, D, G, cid, 1);
        EpiBf16Ssq<true> E{(bf16_t*)(ws + WS_Y), ssq + 4 * T + (_r ? 6 * T : 0), ssq + 2 * T, ssq + 3 * T};
        pg8::gemm_phase<EpiBf16Ssq<true>>(lds, g, So, E); REPSYNC(5); }
        SEAM(5);
    }
    if (IN(6)) { LOADP(); for (int _r = 0; _r < NREP(6); ++_r) { x1_phase(P); REPSYNC(6); } SEAM(6); }
    if (IN(7)) { LOADP();
        for (int _r = 0; _r < NREP(7); ++_r) {
        pg8::Gemm g{(const bf16_t*)(ws + WS_R0), (const bf16_t*)(ws + WS_WGU), T, 2 * DFF, D, D, D}; pg8::StaticOrder So; So.init(T, 2 * DFF, G, cid);
        EpiSwiglu E{(bf16_t*)(ws + WS_ACT)};
        pg8::gemm_phase<EpiSwiglu>(lds, g, So, E); REPSYNC(7); }
        {
            const int t0 = (64 * 86) % G, gp = t0 ? G - t0 : G, cp = t0 ? cid - t0 : cid;
            if (cp >= 0) {
                pg8::Gemm g{(const bf16_t*)(ws + WS_PB), (const bf16_t*)(ws + WS_WPP), T, D, PLE, PLE, PLE}; pg8::StaticOrder So; So.init(T, D, gp, cp);
                EpiBf16 E{(bf16_t*)(ws + WS_PP), D};
                pg8::gemm_phase<EpiBf16>(lds, g, So, E);
            }
        }
        SEAM(7);
    }
    if (IN(8)) { LOADP();
        for (int _r = 0; _r < NREP(8); ++_r) {
        pg8::Gemm g{(const bf16_t*)(ws + WS_ACT), (const bf16_t*)(ws + WS_WDN), T, D, DFF, DFF, DFF}; pg8::StaticOrder So; So.init(T, D, G, cid);
        EpiBf16Ssq<false> E{(bf16_t*)(ws + WS_F), ssq + 5 * T + (_r ? 6 * T : 0), nullptr, nullptr};
        pg8::gemm_phase<EpiBf16Ssq<false>>(lds, g, So, E); REPSYNC(8); }
        SEAM(8);
    }
    if (IN(9)) { LOADP(); x2_phase(P); SEAM(9); }
    if (IN(10)) { LOADP();
        { pg8::Gemm g{(const bf16_t*)(ws + WS_X2B), (const bf16_t*)(ws + WS_WPG), T, D, D, D, D}; pg8::StaticOrder So; So.init(T, D, G, cid);
          EpiPle E{P.out, (const bf16_t*)(ws + WS_PP), (const bf16_t*)(ws + WS_X2B)};
          pg8::gemm_phase<EpiPle>(lds, g, So, E); }
    }
#undef IN
#undef SEAM
#undef NREP
#undef REPSYNC
}

extern "C" void kernel_launch(void* const* d_in, const int* in_sizes, int n_in, void* d_out, int out_size, void* d_ws, size_t ws_size, hipStream_t stream) {
    static int grid = 0;
    if (grid == 0) {
        if (n_in != 21 || out_size != T * D || ws_size < WS_TOTAL) { fprintf(stderr, "kernel_launch: unexpected shapes (n_in %d out %d ws %zu)\n", n_in, out_size, ws_size); grid = -1; return; }
        int dev = 0, cus = 0, per_cu = 0;
        hipGetDevice(&dev);
        hipDeviceGetAttribute(&cus, hipDeviceAttributeMultiprocessorCount, dev);
        if (hipFuncSetAttribute((const void*)mk_fwd, hipFuncAttributeMaxDynamicSharedMemorySize, LDS_BYTES) != hipSuccess) { fprintf(stderr, "kernel_launch: hipFuncSetAttribute failed\n"); grid = -1; return; }
        if (hipOccupancyMaxActiveBlocksPerMultiprocessor(&per_cu, (const void*)mk_fwd, 512, LDS_BYTES) != hipSuccess || per_cu < 1) { fprintf(stderr, "kernel_launch: occupancy query says %d\n", per_cu); per_cu = 1; }
        (void)hipGetLastError();
        grid = cus * 1;
        if (grid <= 0) grid = 256;
    }
    if (grid < 0) return;
    Params a{};
    for (int i = 0; i < 21; ++i) a.in[i] = d_in[i];
    a.out = (float*)d_out; a.ws = (unsigned char*)d_ws;
#if MK_SINGLE
    if (hipMemsetAsync((char*)d_ws + WS_KR, 0, 16384, stream) != hipSuccess) { fprintf(stderr, "kernel_launch: hipMemsetAsync failed\n"); return; }
    a.ph_lo = 0; a.ph_hi = NPHASE;
    void* args[] = {&a};
    hipError_t e = hipLaunchCooperativeKernel((const void*)mk_fwd, dim3(grid), dim3(512), args, LDS_BYTES, stream);
    if (e != hipSuccess) fprintf(stderr, "cooperative launch failed: %s (grid %d)\n", hipGetErrorString(e), grid);
#else
    for (int ph = 0; ph < NPHASE; ++ph) {
        a.ph_lo = ph; a.ph_hi = ph + 1;
        hipLaunchKernelGGL(mk_fwd, dim3(grid), dim3(512), LDS_BYTES, stream, a);
    }
#endif
}
```

```cpp
#include <hip/hip_runtime.h>
#include <hip/hip_cooperative_groups.h>
#include <cstdio>
#include <cstdint>
namespace cg = cooperative_groups;

#ifndef PROBE_PH
#define PROBE_PH -1
#define PROBE_N 1
#endif
#ifndef MK_SINGLE
#define MK_SINGLE 1
#endif

#define DI __device__ __forceinline__
#define LAS __attribute__((address_space(3)))
typedef unsigned short bf16_t;
typedef short bf16x8 __attribute__((ext_vector_type(8)));
typedef float f32x4 __attribute__((ext_vector_type(4)));
typedef float f32x2 __attribute__((ext_vector_type(2)));
typedef float f32x16 __attribute__((ext_vector_type(16)));
typedef unsigned u32x4 __attribute__((ext_vector_type(4)));
typedef unsigned u32x2 __attribute__((ext_vector_type(2)));
typedef __bf16 bf16x2_t __attribute__((ext_vector_type(2)));

constexpr int NB = 2, S = 8192, T = NB * S, D = 4096, DFF = 11008, PLE = 256;
constexpr int DIN_P = 4352;
constexpr int QW = 3072, KNW = 2048;
constexpr float EPS = 1e-6f;
constexpr float LOG2E = 1.4426950408889634f;
constexpr float MLA_QSCALE = 0.10411754627697264f;
constexpr float SWA_QSCALE = 0.18033688011112042f;
constexpr int LDS_BYTES = 163840;
constexpr int VPITCH = S + 128;

constexpr int PJ_CQ = 0, PJ_CKV = 1024, PJ_QS = 1536, PJ_KS = 3584, PJ_VS = 3840, PJ_KR = 4096;

constexpr size_t al256(size_t x) { return (x + 255) & ~(size_t)255; }
constexpr size_t WS_WIN = 0;
constexpr size_t WS_WQUP = WS_WIN + (size_t)DIN_P * D * 2;
constexpr size_t WS_WKVUP = WS_WQUP + (size_t)QW * 1024 * 2;
constexpr size_t WS_WO = WS_WKVUP + (size_t)4096 * 512 * 2;
constexpr size_t WS_WGU = WS_WO + (size_t)D * D * 2;
constexpr size_t WS_WDN = WS_WGU + (size_t)2 * DFF * D * 2;
constexpr size_t WS_WPG = WS_WDN + (size_t)D * DFF * 2;
constexpr size_t WS_WPP = WS_WPG + (size_t)D * D * 2;
constexpr size_t WS_CS = WS_WPP + (size_t)D * PLE * 2;
constexpr size_t WS_SSQ = WS_CS + (size_t)T * 32 * 8;
constexpr size_t WS_PB = WS_SSQ + (size_t)12 * T * 4;
constexpr size_t WS_KR = WS_PB + (size_t)T * PLE * 2;
constexpr size_t WS_KRP = WS_KR + 16384;
constexpr size_t WS_VTS = WS_KRP + (size_t)4 * T * 64 * 4;
constexpr size_t WS_R0 = al256(WS_VTS + (size_t)NB * 4 * 64 * VPITCH * 2);
constexpr size_t WS_B = WS_R0 + (size_t)T * D * 2;
constexpr size_t WS_PROJ = WS_B;
constexpr size_t WS_Q = WS_PROJ + (size_t)T * DIN_P * 2;
constexpr size_t WS_KN = WS_Q + (size_t)T * QW * 2;
constexpr size_t WS_VT = WS_KN + (size_t)T * 3072 * 2;
constexpr size_t WS_VT_END = WS_VT + (size_t)NB * 2048 * VPITCH * 2;
constexpr size_t WS_Y = WS_B;
constexpr size_t WS_TOTAL = (size_t)1 << 30;
constexpr size_t WS_ACT = WS_TOTAL - (size_t)T * DFF * 2;
constexpr size_t WS_F = WS_R0;
constexpr size_t WS_X2B = WS_ACT;
constexpr size_t WS_PP = WS_B;
static_assert(WS_VT_END <= WS_TOTAL, "ws");
static_assert(WS_Y + (size_t)T * D * 4 <= WS_TOTAL, "ws");
static_assert(WS_F + (size_t)T * D * 4 <= WS_ACT, "ws");
static_assert(WS_R0 + (size_t)T * D * 2 <= WS_ACT, "ws");
static_assert(WS_PP + (size_t)T * D * 2 <= WS_ACT, "ws");

DI unsigned pk2(float a, float b) { f32x2 v = {a, b}; return __builtin_bit_cast(unsigned, __builtin_convertvector(v, bf16x2_t)); }
DI bf16_t f2bf(float a) { return (bf16_t)(pk2(a, 0.f) & 0xffffu); }
DI float bflo(unsigned u) { return __uint_as_float(u << 16); }
DI float bfhi(unsigned u) { return __uint_as_float(u & 0xffff0000u); }
DI float wave_sum(float v) {
#pragma unroll
    for (int o = 1; o < 64; o <<= 1) v += __shfl_xor(v, o);
    return v;
}
DI float fast_exp2(float x) { return __builtin_amdgcn_exp2f(x); }
DI float fast_rcp(float x) { return __builtin_amdgcn_rcpf(x); }
DI float sigmoidf_(float v) { return fast_rcp(1.0f + fast_exp2(-v * LOG2E)); }
DI int my_tid() { int t = threadIdx.x; asm volatile("" : "+v"(t)); return t; }
DI float xhalf_max(float v) { const auto r = __builtin_amdgcn_permlane32_swap(__float_as_uint(v), __float_as_uint(v), false, false); return fmaxf(__uint_as_float(r[0]), __uint_as_float(r[1])); }
DI const unsigned char* uni_ptr(const unsigned char* p) { const unsigned long long v = (unsigned long long)p; const unsigned lo = __builtin_amdgcn_readfirstlane((unsigned)v), hi = __builtin_amdgcn_readfirstlane((unsigned)(v >> 32)); return (const unsigned char*)(((unsigned long long)hi << 32) | lo); }
DI void dma16(const unsigned char* sbase, unsigned voff, unsigned ldsaddr) { asm volatile("s_mov_b32 m0, %0\n\ts_nop 0\n\tglobal_load_lds_dwordx4 %1, %2" :: "s"(ldsaddr), "v"(voff), "s"(sbase) : "memory"); }
DI int pi32(int i) { return (i & ~12) | ((i & 4) << 1) | ((i & 8) >> 1); }


#define XB_TMO      128
#define XB_XCNT(j)  (256  + 64 * (j))
#define XB_XSUB(j)  (1280 + 64 * (j))
#define XB_XGEN(j)  (2304 + 64 * (j))
#define XB_TOP      3328
#define XB_TOPGEN   3392
#define XB_SLOT(w)  (3456 + 2 * (w))
#define XB_WORDS    4096
#define XB_SPIN_CAP (1u << 20)
DI unsigned xb_ld(unsigned* p) { return __hip_atomic_load(p, __ATOMIC_RELAXED, __HIP_MEMORY_SCOPE_AGENT); }
DI unsigned xb_add(unsigned* p, unsigned v) { return __hip_atomic_fetch_add(p, v, __ATOMIC_RELAXED, __HIP_MEMORY_SCOPE_AGENT); }
DI unsigned xb_xcc_id() { return (unsigned)__builtin_amdgcn_s_getreg((3 << 11) | 20) & 0xFu; }
#define XB_SPIN(cond, bar) do { unsigned _sp = 0; while (cond) { __builtin_amdgcn_s_sleep(1); \
    if ((++_sp & 255u) == 0u) { if (xb_ld(&(bar)[XB_TMO])) break; if (_sp > XB_SPIN_CAP) { xb_add(&(bar)[XB_TMO], 1u); break; } } } } while (0)
DI void xcd_barrier_post(unsigned* bar) { if (threadIdx.x == 0) (void)xb_add(&bar[XB_XCNT(xb_xcc_id())], 1u); }
DI void xcd_barrier(unsigned* bar) {
    asm volatile("s_waitcnt vmcnt(0) lgkmcnt(0)" ::: "memory");
    __syncthreads();
    if (threadIdx.x == 0) {
        const unsigned x = xb_xcc_id(), G = gridDim.x;
        unsigned nloc = xb_ld(&bar[XB_SLOT(blockIdx.x)]), nx = xb_ld(&bar[XB_SLOT(blockIdx.x) + 1]);
        if (nloc == 0u) {
            unsigned sum, cnt, mine, sp = 0u;
            for (;;) {
                sum = 0u; cnt = 0u; mine = 0u;
#pragma unroll
                for (unsigned j = 0; j < 16; ++j) { const unsigned c = xb_ld(&bar[XB_XCNT(j)]); sum += c; cnt += (c > 0u) ? 1u : 0u; mine = (j == x) ? c : mine; }
                if (sum == G) break;
                __builtin_amdgcn_s_sleep(1);
                if ((++sp & 255u) == 0u) { if (xb_ld(&bar[XB_TMO])) break; if (sp > XB_SPIN_CAP) { xb_add(&bar[XB_TMO], 1u); break; } }
            }
            nloc = mine > 0u ? mine : 1u; nx = cnt > 0u ? cnt : 1u;
            __hip_atomic_store(&bar[XB_SLOT(blockIdx.x)], nloc, __ATOMIC_RELAXED, __HIP_MEMORY_SCOPE_AGENT); __hip_atomic_store(&bar[XB_SLOT(blockIdx.x) + 1], nx, __ATOMIC_RELAXED, __HIP_MEMORY_SCOPE_AGENT);
        }
        const unsigned old = xb_add(&bar[XB_XSUB(x)], 1u);
        const unsigned gen = old / nloc;
        if (old + 1u == (gen + 1u) * nloc) {
            __builtin_amdgcn_fence(__ATOMIC_RELEASE, "agent");
            asm volatile("s_waitcnt vmcnt(0)" ::: "memory");
            const unsigned og = xb_add(&bar[XB_TOP], 1u);
            const unsigned tg = og / nx;
            if (og + 1u == (tg + 1u) * nx) xb_add(&bar[XB_TOPGEN], 1u);
            else XB_SPIN(xb_ld(&bar[XB_TOPGEN]) == tg, bar);
            __builtin_amdgcn_fence(__ATOMIC_ACQUIRE, "agent");
            xb_add(&bar[XB_XGEN(x)], 1u);
            asm volatile("s_waitcnt vmcnt(0)" ::: "memory");
        } else {
            XB_SPIN(xb_ld(&bar[XB_XGEN(x)]) == gen, bar);
            __builtin_amdgcn_fence(__ATOMIC_ACQUIRE, "agent");
            asm volatile("s_waitcnt vmcnt(0)" ::: "memory");
        }
    }
    __syncthreads();
}

namespace pg8 {
constexpr int BM = 256, BK = 64, HALF = 128, HTB = HALF * BK * 2, STAGE_BYTES = 8 * HTB, NXCD = 8, WGM = 8;
DI int lds_byte(int r, int c) { const int st = (r >> 4) * 2 + (c >> 5), rr = r & 15, cc = c & 31, ob = rr * 64 + cc * 2; return st * 1024 + (ob ^ (((ob >> 9) & 1) << 5)); }
DI void stage_rc(int b, int& R, int& C) { const int st = b / 1024, sb = b % 1024, swz = sb ^ (((sb >> 9) & 1) << 5); R = (st >> 1) * 16 + swz / 64; C = (st & 1) * 32 + (swz % 64) / 2; }
DI int perm32(int rho) { const int n = rho >> 4, i = rho & 15; return 8 * (i >> 2) + 4 * n + (i & 3); }

struct Unit { int pm, pn, half; };
struct Gemm { const bf16_t* A; const bf16_t* Bt; int M, N, K, lda, ldb; };

struct StaticOrder {
    int nM, nN, nwg, G, c, split;
    DI void init(int M, int N, int G_, int c_, int split_ = 0) { nM = M / BM; nN = N / BM; nwg = nM * nN; G = G_; c = c_; split = split_; }
    DI bool next(int i, Unit& u) const {
        if (split == 2) { const long L4 = (long)i * G + c; if (L4 >= 4L * nM) return false; u.pm = (int)(L4 >> 2); u.pn = 0; u.half = (int)(L4 & 3); return true; }
        u.half = split ? (i & 1) : 1; if (split) i >>= 1;
        const long L = (long)i * G + c; if (L >= nwg) return false;
        int wgid = (int)L; { const int q = nwg / NXCD, r = nwg % NXCD, xcd = wgid % NXCD, off = wgid / NXCD; wgid = (xcd < r ? xcd * (q + 1) : r * (q + 1) + (xcd - r) * q) + off; }
        const int nig = WGM * nN, gid = wgid / nig, fm = gid * WGM, gsz = (nM - fm) < WGM ? (nM - fm) : WGM;
        u.pm = fm + ((wgid % nig) % gsz); u.pn = (wgid % nig) / gsz; return true;
    }
};

template <class Epi>
DI void gemm_phase(LAS unsigned char* lds, const Gemm g, const StaticOrder& S, const Epi& E) {
    const int tid = my_tid(), wid = __builtin_amdgcn_readfirstlane(tid >> 6), lane = tid & 63, wr = wid >> 2, wc = wid & 3, fr = lane & 15, fq = lane >> 4;
    int K = g.K; asm volatile("" : "+s"(K));
    const int nt = K / BK;
    unsigned voffA[2], voffB[2];
#pragma unroll
    for (int i = 0; i < 2; ++i) { int R, C; stage_rc(tid * 16 + i * 8192, R, C); const int Rb = Epi::PERM ? ((R & ~31) + perm32(R & 31)) : R;
        voffA[i] = (unsigned)(R * g.lda + C) * 2u; voffB[i] = (unsigned)(Rb * g.ldb + C) * 2u; }
    const size_t kstep = (size_t)(BK * 2);
    const size_t hstepA = (size_t)HALF * g.lda * 2, hstepB = (size_t)HALF * g.ldb * 2;
    const size_t tstepA = 2 * hstepA, tstepB = 2 * hstepB;
    const unsigned ldsw = (unsigned)wid * 1024u;
    const int aoff = lds_byte(wr * 64 + fr, fq * 8), boff = lds_byte(wc * 32 + fr, fq * 8);
#define PG8_SA(b, h) (((b) * 2 + (h)) * HTB)
#define PG8_SB(b, h) ((4 + (b) * 2 + (h)) * HTB)
#define PG8_STAGE(bufoff, gbase, voff) do { _Pragma("unroll") for (int _i = 0; _i < 2; ++_i) \
        __builtin_amdgcn_global_load_lds((const unsigned*)((const char*)(gbase) + (voff)[_i]), (LAS unsigned*)(lds + (bufoff) + ldsw + _i * 8192), 16, 0, 0); } while (0)
#define PG8_LDA(dst, b, h) do { _Pragma("unroll") for (int m = 0; m < 4; ++m) _Pragma("unroll") for (int k = 0; k < 2; ++k) dst[m][k] = *(const LAS bf16x8*)(lds + PG8_SA(b, h) + aoff + m * 2048 + k * 1024); } while (0)
#define PG8_LDB(dst, b, h) do { _Pragma("unroll") for (int n = 0; n < 2; ++n) _Pragma("unroll") for (int k = 0; k < 2; ++k) dst[n][k] = *(const LAS bf16x8*)(lds + PG8_SB(b, h) + boff + n * 2048 + k * 1024); } while (0)
#define PG8_MMA(ai, bj, At, Bt) do { __builtin_amdgcn_s_setprio(1); _Pragma("unroll") for (int m = 0; m < 4; ++m) _Pragma("unroll") for (int n = 0; n < 2; ++n) _Pragma("unroll") for (int k = 0; k < 2; ++k) \
        acc[ai][bj][m][n] = __builtin_amdgcn_mfma_f32_16x16x32_bf16(Bt[n][k], At[m][k], acc[ai][bj][m][n], 0, 0, 0); __builtin_amdgcn_s_setprio(0); } while (0)
#define PG8_WAIT_V(n) asm volatile("s_waitcnt vmcnt(" #n ")" ::: "memory")
#define PG8_WAIT_L(n) asm volatile("s_waitcnt lgkmcnt(" #n ")" ::: "memory")
#define PG8_BAR __builtin_amdgcn_s_barrier()
#define PG8_SCHED __builtin_amdgcn_sched_barrier(0)
    Unit cur, nxt; int ui = 0;
    if (!S.next(0, cur)) return;
    f32x4 acc[2][2][4][2];
#pragma unroll
    for (int a = 0; a < 2; ++a)
#pragma unroll
        for (int b = 0; b < 2; ++b)
#pragma unroll
            for (int m = 0; m < 4; ++m)
#pragma unroll
                for (int n = 0; n < 2; ++n) acc[a][b][m][n] = (f32x4){0.f, 0.f, 0.f, 0.f};
    bf16x8 At[4][2], B0[2][2], B1[2][2];
#define PG8_KOFF(u) ((Epi::MIDK || Epi::KSPLIT) ? (size_t)(u).half * (size_t)K * 2 : (size_t)0)
    const char* cA = (const char*)g.A + (size_t)cur.pm * tstepA + PG8_KOFF(cur); const char* cB = (const char*)g.Bt + (size_t)cur.pn * tstepB + PG8_KOFF(cur);
    PG8_STAGE(PG8_SB(0, 0), cB, voffB); PG8_STAGE(PG8_SB(0, 1), cB + hstepB, voffB); PG8_STAGE(PG8_SA(0, 0), cA, voffA); PG8_STAGE(PG8_SA(0, 1), cA + hstepA, voffA);
    if (wr == 1) PG8_BAR;
    PG8_WAIT_V(2); PG8_BAR;
    PG8_STAGE(PG8_SB(1, 0), cB + kstep, voffB); PG8_STAGE(PG8_SA(1, 0), cA + kstep, voffA); PG8_STAGE(PG8_SB(1, 1), cB + hstepB + kstep, voffB);
    PG8_WAIT_V(6); PG8_BAR;
    for (;;) {
        const bool has_next = S.next(ui + 1, nxt);
        const char* nA = has_next ? (const char*)g.A + (size_t)nxt.pm * tstepA + PG8_KOFF(nxt) : cA; const char* nB = has_next ? (const char*)g.Bt + (size_t)nxt.pn * tstepB + PG8_KOFF(nxt) : cB;
        for (int t = 0; t < nt; t += 2) {
            const bool last = (t == nt - 2);
            const char* a1 = cA + (size_t)(t + 1) * kstep;
            const char* a2 = last ? nA : cA + (size_t)(t + 2) * kstep; const char* b2 = last ? nB : cB + (size_t)(t + 2) * kstep;
            const char* a3 = a2 + kstep; const char* b3 = b2 + kstep;
            PG8_LDB(B0, 0, 0); PG8_LDB(B1, 0, 1); PG8_SCHED; PG8_LDA(At, 0, 0); PG8_STAGE(PG8_SA(1, 1), a1 + hstepA, voffA);
            PG8_WAIT_V(8); PG8_WAIT_L(0); PG8_BAR; PG8_MMA(0, 0, At, B0); PG8_MMA(0, 1, At, B1); PG8_BAR; PG8_SCHED;
            PG8_LDA(At, 0, 1); PG8_STAGE(PG8_SB(0, 0), b2, voffB); PG8_STAGE(PG8_SB(0, 1), b2 + hstepB, voffB); PG8_STAGE(PG8_SA(0, 0), a2, voffA);
            PG8_WAIT_V(8); PG8_WAIT_L(0); PG8_BAR; PG8_MMA(1, 0, At, B0); PG8_MMA(1, 1, At, B1); PG8_BAR; PG8_SCHED;
            PG8_LDB(B0, 1, 0); PG8_LDB(B1, 1, 1); PG8_SCHED; PG8_LDA(At, 1, 0); PG8_STAGE(PG8_SA(0, 1), a2 + hstepA, voffA);
            PG8_WAIT_V(8); PG8_WAIT_L(0); PG8_BAR; PG8_MMA(0, 0, At, B0); PG8_MMA(0, 1, At, B1); PG8_BAR; PG8_SCHED;
            PG8_LDA(At, 1, 1); PG8_STAGE(PG8_SB(1, 0), b3, voffB); PG8_STAGE(PG8_SB(1, 1), b3 + hstepB, voffB); PG8_STAGE(PG8_SA(1, 0), a3, voffA);
            PG8_WAIT_V(8); PG8_WAIT_L(0); PG8_BAR; PG8_MMA(1, 0, At, B0); PG8_MMA(1, 1, At, B1); PG8_BAR; PG8_SCHED;
        }
        if (wr == 0) PG8_BAR;
        bool keep = false;
        if constexpr (Epi::MIDK) { if (cur.half == 0) { E.mid(acc, cur, wr, wc, fr, fq); keep = true; } else E(acc, cur, wr, wc, fr, fq); } else E(acc, cur, wr, wc, fr, fq);
        if (!has_next) break;
        if (!keep)
#pragma unroll
        for (int a = 0; a < 2; ++a)
#pragma unroll
            for (int b = 0; b < 2; ++b)
#pragma unroll
                for (int m = 0; m < 4; ++m)
#pragma unroll
                    for (int n = 0; n < 2; ++n) acc[a][b][m][n] = (f32x4){0.f, 0.f, 0.f, 0.f};
        cur = nxt; cA = nA; cB = nB; ++ui;
        if (wr == 1) PG8_BAR;
    }
    PG8_WAIT_V(0);
    PG8_BAR;
#undef PG8_SA
#undef PG8_KOFF
#undef PG8_SB
#undef PG8_STAGE
#undef PG8_LDA
#undef PG8_LDB
#undef PG8_MMA
#undef PG8_WAIT_V
#undef PG8_WAIT_L
#undef PG8_BAR
#undef PG8_SCHED
}
}
using pg8::Unit;

typedef const f32x4 (&AccRef)[2][2][4][2];

DI float row_sq(AccRef acc, int ai, int m) {
    float s = 0.f;
#pragma unroll
    for (int bj = 0; bj < 2; ++bj)
#pragma unroll
        for (int n = 0; n < 2; ++n) { const f32x4 v = acc[ai][bj][m][n]; s += (v[0] * v[0] + v[1] * v[1]) + (v[2] * v[2] + v[3] * v[3]); }
    s += __shfl_xor(s, 16); s += __shfl_xor(s, 32);
    return s;
}
DI u32x4 pack8(f32x4 v0, f32x4 v1) { u32x4 w; w.x = pk2(v0[0], v0[1]); w.y = pk2(v0[2], v0[3]); w.z = pk2(v1[0], v1[1]); w.w = pk2(v1[2], v1[3]); return w; }
DI void rope8(f32x4& v0, f32x4& v1, const f32x2* cs) {
    const f32x4 c01 = *(const f32x4*)cs, c23 = *(const f32x4*)(cs + 2);
    f32x4 r0, r1;
    r0[0] = v0[0] * c01[0] - v0[1] * c01[1]; r0[1] = v0[0] * c01[1] + v0[1] * c01[0];
    r0[2] = v0[2] * c01[2] - v0[3] * c01[3]; r0[3] = v0[2] * c01[3] + v0[3] * c01[2];
    r1[0] = v1[0] * c23[0] - v1[1] * c23[1]; r1[1] = v1[0] * c23[1] + v1[1] * c23[0];
    r1[2] = v1[2] * c23[2] - v1[3] * c23[3]; r1[3] = v1[2] * c23[3] + v1[3] * c23[2];
    v0 = r0; v1 = r1;
}

struct EpiIn {
    static constexpr bool PERM = true, MIDK = false, KSPLIT = false;
    bf16_t* proj; float* ssq_q; float* ssq_kv; bf16_t* vts; bf16_t* kr; const f32x2* cs;
    DI void operator()(AccRef acc, const Unit& u, int wr, int wc, int fr, int fq) const {
        const int row0 = u.pm * 256 + wr * 64 + fr, colt = u.pn * 256, lc0 = wc * 32 + 8 * fq;
#pragma unroll
        for (int ai = 0; ai < 2; ++ai)
#pragma unroll
            for (int m = 0; m < 4; ++m) {
                const int row = row0 + ai * 128 + m * 16;
                bf16_t* rp = proj + (size_t)row * DIN_P + colt + lc0;
#pragma unroll
                for (int bj = 0; bj < 2; ++bj) *(u32x4*)(rp + bj * 128) = pack8(acc[ai][bj][m][0], acc[ai][bj][m][1]);
            }
        if (u.pn < 6) {
            float* sq = u.pn < 4 ? ssq_q : ssq_kv;
#pragma unroll
            for (int ai = 0; ai < 2; ++ai)
#pragma unroll
                for (int m = 0; m < 4; ++m) { const float s = row_sq(acc, ai, m); if (fq == 0) unsafeAtomicAdd(sq + row0 + ai * 128 + m * 16, s); }
        }
    }
};

struct EpiKr {
    static constexpr bool PERM = true, MIDK = false, KSPLIT = true;
    float* krp;
    DI void operator()(AccRef acc, const Unit& u, int wr, int wc, int fr, int fq) const {
        if (wc >= 2) return;
        const int row0 = u.pm * 256 + wr * 64 + fr, lc0 = wc * 32 + 8 * fq;
#pragma unroll
        for (int ai = 0; ai < 2; ++ai)
#pragma unroll
            for (int m = 0; m < 4; ++m) {
                float* rp = krp + ((size_t)u.half * T + row0 + ai * 128 + m * 16) * 64 + lc0;
                *(f32x4*)rp = acc[ai][0][m][0]; *(f32x4*)(rp + 4) = acc[ai][0][m][1];
            }
    }
};

struct EpiVt {
    static constexpr bool PERM = true, MIDK = false, KSPLIT = false;
    bf16_t* out; int rows_per_batch; const float* ssq; float inv_dim;
    DI void operator()(AccRef acc, const Unit& u, int wr, int wc, int fr, int fq) const {
        const int n0 = u.pm * 256 + wr * 64 + fr, t0 = u.pn * 256 + wc * 32 + 8 * fq, b = t0 >> 13, s0 = t0 & (S - 1);
        f32x4 sc[2][2];
#pragma unroll
        for (int bj = 0; bj < 2; ++bj)
#pragma unroll
            for (int n = 0; n < 2; ++n) {
                if (ssq) { const f32x4 q = *(const f32x4*)(ssq + t0 + bj * 128 + 4 * n);
#pragma unroll
                    for (int j = 0; j < 4; ++j) sc[bj][n][j] = rsqrtf(q[j] * inv_dim + EPS);
                } else sc[bj][n] = (f32x4){1.f, 1.f, 1.f, 1.f};
            }
#pragma unroll
        for (int ai = 0; ai < 2; ++ai)
#pragma unroll
            for (int m = 0; m < 4; ++m) {
                bf16_t* rp = out + ((size_t)(b * rows_per_batch + n0 + ai * 128 + m * 16)) * VPITCH + s0;
#pragma unroll
                for (int bj = 0; bj < 2; ++bj) *(u32x4*)(rp + bj * 128) = pack8(acc[ai][bj][m][0] * sc[bj][0], acc[ai][bj][m][1] * sc[bj][1]);
            }
    }
};

template <int MODE> struct EpiUp {
    static constexpr bool PERM = true, MIDK = false, KSPLIT = false;
    const float* ssq; float inv_dim, mul; bf16_t* out; int ldc; const f32x2* cs; bf16_t* vt;
    template <bool ROPE> DI void run(AccRef acc, const Unit& u, int wr, int wc, int fr, int fq) const {
        const int row0 = u.pm * 256 + wr * 64 + fr, colt = u.pn * 256, lc0 = wc * 32 + 8 * fq;
        float sc[2][4];
#pragma unroll
        for (int ai = 0; ai < 2; ++ai)
#pragma unroll
            for (int m = 0; m < 4; ++m) sc[ai][m] = ssq[row0 + ai * 128 + m * 16];
#pragma unroll
        for (int ai = 0; ai < 2; ++ai) {
            f32x4 c01[4], c23[4];
            if (ROPE) {
#pragma unroll
                for (int m = 0; m < 4; ++m) { const f32x2* cp = cs + (size_t)(row0 + ai * 128 + m * 16) * 32 + (wc & 1) * 16 + 4 * fq; c01[m] = *(const f32x4*)cp; c23[m] = *(const f32x4*)(cp + 2); }
            }
#pragma unroll
            for (int m = 0; m < 4; ++m) {
                const int row = row0 + ai * 128 + m * 16;
                const float scl = rsqrtf(sc[ai][m] * inv_dim + EPS) * mul;
#pragma unroll
                for (int bj = 0; bj < 2; ++bj) {
                    f32x4 v0 = acc[ai][bj][m][0] * scl, v1 = acc[ai][bj][m][1] * scl;
                    if (ROPE) {
                        const f32x4 a = c01[m], bq = c23[m]; f32x4 r0, r1;
                        r0[0] = v0[0] * a[0] - v0[1] * a[1]; r0[1] = v0[0] * a[1] + v0[1] * a[0];
                        r0[2] = v0[2] * a[2] - v0[3] * a[3]; r0[3] = v0[2] * a[3] + v0[3] * a[2];
                        r1[0] = v1[0] * bq[0] - v1[1] * bq[1]; r1[1] = v1[0] * bq[1] + v1[1] * bq[0];
                        r1[2] = v1[2] * bq[2] - v1[3] * bq[3]; r1[3] = v1[2] * bq[3] + v1[3] * bq[2];
                        v0 = r0; v1 = r1;
                    }
                    if (MODE == 1) *(u32x4*)(out + (size_t)row * 3072 + (u.pn * 2 + bj) * 192 + lc0) = pack8(v0, v1);
                    else *(u32x4*)(out + (size_t)row * ldc + colt + bj * 128 + lc0) = pack8(v0, v1);
                }
            }
        }
    }
    DI void operator()(AccRef acc, const Unit& u, int wr, int wc, int fr, int fq) const {
        if (MODE == 0 && u.pn >= 8) run<true>(acc, u, wr, wc, fr, fq); else run<false>(acc, u, wr, wc, fr, fq);
    }
};

template <bool MIDK_> struct EpiBf16Ssq {
    static constexpr bool PERM = true, MIDK = MIDK_, KSPLIT = false;
    bf16_t* C; float* ssq; const float* ssqA; const float* ssqB;
    DI void mid(f32x4 (&acc)[2][2][4][2], const Unit& u, int wr, int wc, int fr, int fq) const {
        const int row0 = u.pm * 256 + wr * 64 + fr;
#pragma unroll
        for (int ai = 0; ai < 2; ++ai)
#pragma unroll
            for (int m = 0; m < 4; ++m) {
                const int row = row0 + ai * 128 + m * 16;
                const float ratio = rsqrtf(ssqA[row] * (1.0f / 2048.0f) + EPS) * sqrtf(ssqB[row] * (1.0f / 2048.0f) + EPS);
#pragma unroll
                for (int bj = 0; bj < 2; ++bj)
#pragma unroll
                    for (int n = 0; n < 2; ++n) acc[ai][bj][m][n] *= ratio;
            }
    }
    DI void operator()(AccRef acc, const Unit& u, int wr, int wc, int fr, int fq) const {
        const int row0 = u.pm * 256 + wr * 64 + fr, col0 = u.pn * 256 + wc * 32 + 8 * fq;
        float sb[2][4];
        if (MIDK) {
#pragma unroll
            for (int ai = 0; ai < 2; ++ai)
#pragma unroll
                for (int m = 0; m < 4; ++m) sb[ai][m] = ssqB[row0 + ai * 128 + m * 16];
        }
#pragma unroll
        for (int ai = 0; ai < 2; ++ai)
#pragma unroll
            for (int m = 0; m < 4; ++m) {
                const int row = row0 + ai * 128 + m * 16;
                float sc = 1.0f;
                if (MIDK) sc = rsqrtf(sb[ai][m] * (1.0f / 2048.0f) + EPS);
                bf16_t* rp = C + (size_t)row * D + col0;
#pragma unroll
                for (int bj = 0; bj < 2; ++bj) *(u32x4*)(rp + bj * 128) = pack8(acc[ai][bj][m][0] * sc, acc[ai][bj][m][1] * sc);
                const float s = row_sq(acc, ai, m) * sc * sc; if (fq == 0) unsafeAtomicAdd(ssq + row, s);
            }
    }
};

struct EpiSwiglu {
    static constexpr bool PERM = true, MIDK = false, KSPLIT = false;
    bf16_t* act;
    DI void operator()(AccRef acc, const Unit& u, int wr, int wc, int fr, int fq) const {
        const int row0 = u.pm * 256 + wr * 64 + fr, col0 = u.pn * 128 + wc * 32 + 8 * fq;
#pragma unroll
        for (int ai = 0; ai < 2; ++ai)
#pragma unroll
            for (int m = 0; m < 4; ++m) {
                const int row = row0 + ai * 128 + m * 16;
                f32x4 r[2];
#pragma unroll
                for (int n = 0; n < 2; ++n)
#pragma unroll
                    for (int j = 0; j < 4; ++j) { const float gt = acc[ai][0][m][n][j], up = acc[ai][1][m][n][j]; r[n][j] = gt * sigmoidf_(gt) * up; }
                *(u32x4*)(act + (size_t)row * DFF + col0) = pack8(r[0], r[1]);
            }
    }
};

struct EpiBf16 {
    static constexpr bool PERM = true, MIDK = false, KSPLIT = false;
    bf16_t* out; int ldc;
    DI void operator()(AccRef acc, const Unit& u, int wr, int wc, int fr, int fq) const {
        const int row0 = u.pm * 256 + wr * 64 + fr, col0 = u.pn * 256 + wc * 32 + 8 * fq;
#pragma unroll
        for (int ai = 0; ai < 2; ++ai)
#pragma unroll
            for (int m = 0; m < 4; ++m) {
                bf16_t* rp = out + (size_t)(row0 + ai * 128 + m * 16) * ldc + col0;
#pragma unroll
                for (int bj = 0; bj < 2; ++bj) *(u32x4*)(rp + bj * 128) = pack8(acc[ai][bj][m][0], acc[ai][bj][m][1]);
            }
    }
};

struct EpiPle {
    static constexpr bool PERM = true, MIDK = false, KSPLIT = false;
    float* out; const bf16_t* pp; const bf16_t* x2b;
    DI void operator()(AccRef acc, const Unit& u, int wr, int wc, int fr, int fq) const {
        const int row0 = u.pm * 256 + wr * 64 + fr, col0 = u.pn * 256 + wc * 32 + 8 * fq;
#pragma unroll
        for (int ai = 0; ai < 2; ++ai) {
            u32x4 pv[4][2], xv[4][2];
#pragma unroll
            for (int m = 0; m < 4; ++m)
#pragma unroll
                for (int bj = 0; bj < 2; ++bj) { const size_t o = (size_t)(row0 + ai * 128 + m * 16) * D + col0 + bj * 128; pv[m][bj] = *(const u32x4*)(pp + o); xv[m][bj] = *(const u32x4*)(x2b + o); }
#pragma unroll
            for (int m = 0; m < 4; ++m)
#pragma unroll
                for (int bj = 0; bj < 2; ++bj) {
                    float* op = out + (size_t)(row0 + ai * 128 + m * 16) * D + col0 + bj * 128;
                    const u32x4 p4 = pv[m][bj], x4 = xv[m][bj];
                    const f32x4 a0 = acc[ai][bj][m][0], a1 = acc[ai][bj][m][1];
                    f32x4 x0, x1;
                    x0[0] = bflo(x4.x) + sigmoidf_(a0[0]) * bflo(p4.x); x0[1] = bfhi(x4.x) + sigmoidf_(a0[1]) * bfhi(p4.x);
                    x0[2] = bflo(x4.y) + sigmoidf_(a0[2]) * bflo(p4.y); x0[3] = bfhi(x4.y) + sigmoidf_(a0[3]) * bfhi(p4.y);
                    x1[0] = bflo(x4.z) + sigmoidf_(a1[0]) * bflo(p4.z); x1[1] = bfhi(x4.z) + sigmoidf_(a1[1]) * bfhi(p4.z);
                    x1[2] = bflo(x4.w) + sigmoidf_(a1[2]) * bflo(p4.w); x1[3] = bfhi(x4.w) + sigmoidf_(a1[3]) * bfhi(p4.w);
                    *(f32x4*)op = x0; *(f32x4*)(op + 4) = x1;
                }
        }
    }
};

struct TDesc { const float* src; int N; int c0; bf16_t* dst; int ldk; int n0; int perm; const float* rowscale; float colscale; const float* rowscale_hi; };

typedef const float __attribute__((address_space(1)))* gfp_t;
typedef const f32x4 __attribute__((address_space(1)))* gf4p_t;
DI void transpose_item(const TDesc& d, int kt, LAS float* scr, int lane) {
    const int k0 = kt * 64;
    const int lr = lane >> 4, lc = (lane & 15) * 4;
    f32x4 v[16]; float rsv[16];
    const gfp_t src = (gfp_t)(d.src + (size_t)(k0 + lr) * d.N + d.c0 + lc);
#pragma unroll
    for (int i = 0; i < 16; ++i) v[i] = *(gf4p_t)(src + (size_t)(4 * i) * d.N);
    if (d.rowscale) {
        const gfp_t rsp = (gfp_t)(((d.rowscale_hi && k0 >= 2048) ? d.rowscale_hi + (k0 - 2048) : d.rowscale + k0) + lr);
#pragma unroll
        for (int i = 0; i < 16; ++i) rsv[i] = rsp[4 * i] * d.colscale;
    } else {
#pragma unroll
        for (int i = 0; i < 16; ++i) rsv[i] = d.colscale;
    }
#pragma unroll
    for (int i = 0; i < 16; ++i) {
        LAS float* sp = scr + (4 * i + lr) * 65 + lc;
        sp[0] = v[i][0] * rsv[i]; sp[1] = v[i][1] * rsv[i]; sp[2] = v[i][2] * rsv[i]; sp[3] = v[i][3] * rsv[i];
    }
    asm volatile("s_waitcnt lgkmcnt(0)" ::: "memory");
    const int c = lane & 7;
#pragma unroll
    for (int j = 0; j < 8; ++j) {
        const int n = (lane >> 3) + 8 * j;
        const int sn = d.perm ? ((n >> 1) + 32 * (n & 1)) : n;
        const LAS float* s = scr + (8 * c) * 65 + sn;
        u32x4 o; o.x = pk2(s[0], s[65]); o.y = pk2(s[130], s[195]); o.z = pk2(s[260], s[325]); o.w = pk2(s[390], s[455]);
        *(u32x4 __attribute__((address_space(1)))*)(d.dst + (size_t)(d.n0 + n) * d.ldk + k0 + 8 * c) = o;
    }
    asm volatile("s_waitcnt lgkmcnt(0)" ::: "memory");
}

struct Ptrs {
    const float *x, *p; const int* pos; const float *g_attn_pre, *w_in, *g_qa, *w_qup, *g_kva, *w_kvup, *sinks, *g_mla, *g_swa, *w_o, *g_attn_post, *g_ffn_pre,
        *w_gate, *w_up, *w_down, *g_ffn_post, *w_pg, *w_pp;
    float* out; unsigned char* ws;
};

constexpr int IT_IN = 65 * 64, IT_QUP = 48 * 16, IT_KVUP = 64 * 8, IT_O = 64 * 64, IT_GU = 344 * 64, IT_DN = 64 * 172, IT_PG = 64 * 64, IT_PP = 64 * 4;
constexpr int IT_TOTAL = IT_IN + IT_QUP + IT_KVUP + IT_O + IT_GU + IT_DN + IT_PG + IT_PP;

DI void conv_item(const Ptrs& P, int it, LAS float* scr, int lane) {
    TDesc d; int kt; d.perm = 0; d.rowscale = nullptr; d.colscale = 1.0f; d.rowscale_hi = nullptr;
    unsigned char* ws = P.ws;
    if (it < IT_IN) { const int jt = it % 65; kt = it / 65; d.src = P.w_in; d.N = 4160; d.dst = (bf16_t*)(ws + WS_WIN); d.ldk = D; d.n0 = jt * 64;
        if (jt < 24) d.c0 = 64 * jt; else if (jt < 56) { d.c0 = 1600 + 64 * (jt - 24); d.colscale = SWA_QSCALE; } else if (jt < 64) d.c0 = 3648 + 64 * (jt - 56); else { d.c0 = 1536; d.perm = 1; }
    } else if ((it -= IT_IN) < IT_QUP) { const int jt = it % 48; kt = it / 48; d.src = P.w_qup; d.N = 3072; d.dst = (bf16_t*)(ws + WS_WQUP); d.ldk = 1024; d.n0 = jt * 64; d.rowscale = P.g_qa;
        if (jt < 32) d.c0 = (jt >> 1) * 192 + 64 * (jt & 1); else { d.c0 = (jt - 32) * 192 + 128; d.perm = 1; }
    } else if ((it -= IT_QUP) < IT_KVUP) { const int jt = it % 64; kt = it / 64; d.src = P.w_kvup; d.N = 4096; d.dst = (bf16_t*)(ws + WS_WKVUP); d.ldk = 512; d.n0 = jt * 64; d.rowscale = P.g_kva;
        if (jt < 32) d.c0 = (jt >> 1) * 256 + 64 * (jt & 1); else d.c0 = ((jt - 32) >> 1) * 256 + 128 + 64 * (jt & 1);
    } else if ((it -= IT_KVUP) < IT_O) { const int jt = it % 64; kt = it / 64; d.src = P.w_o; d.N = D; d.dst = (bf16_t*)(ws + WS_WO); d.ldk = D; d.n0 = jt * 64; d.c0 = jt * 64; d.rowscale = P.g_mla; d.rowscale_hi = P.g_swa;
    } else if ((it -= IT_O) < IT_GU) { const int jt = it % 344; kt = it / 344; const int t = jt >> 2, sub = jt & 3; d.src = sub < 2 ? P.w_gate : P.w_up; d.N = DFF; d.dst = (bf16_t*)(ws + WS_WGU); d.ldk = D; d.n0 = jt * 64;
        d.c0 = 128 * t + 64 * (sub & 1);
    } else if ((it -= IT_GU) < IT_DN) { const int jt = it % 64; kt = it / 64; d.src = P.w_down; d.N = D; d.dst = (bf16_t*)(ws + WS_WDN); d.ldk = DFF; d.n0 = jt * 64; d.c0 = jt * 64;
    } else if ((it -= IT_DN) < IT_PG) { const int jt = it % 64; kt = it / 64; d.src = P.w_pg; d.N = D; d.dst = (bf16_t*)(ws + WS_WPG); d.ldk = D; d.n0 = jt * 64; d.c0 = jt * 64;
    } else { it -= IT_PG; const int jt = it % 64; kt = it / 64; d.src = P.w_pp; d.N = D; d.dst = (bf16_t*)(ws + WS_WPP); d.ldk = PLE; d.n0 = jt * 64; d.c0 = jt * 64; }
    transpose_item(d, kt, scr, lane);
}

DI void sincos_d(double a, float& c, float& s) {
    const double n = __builtin_rint(a * 0.15915494309189535);
    double r = __builtin_fma(-n, 6.283185307179586, a);
    r = __builtin_fma(-n, 2.4492935982947064e-16, r);
    double sg = 1.0;
    if (r > 1.5707963267948966) { r = 3.141592653589793 - r; sg = -1.0; }
    else if (r < -1.5707963267948966) { r = -3.141592653589793 - r; sg = -1.0; }
    const double r2 = r * r;
    double ps = -1.0 / 1307674368000.0;
    ps = ps * r2 + 1.0 / 6227020800.0; ps = ps * r2 - 1.0 / 39916800.0; ps = ps * r2 + 1.0 / 362880.0; ps = ps * r2 - 1.0 / 5040.0;
    ps = ps * r2 + 1.0 / 120.0; ps = ps * r2 - 1.0 / 6.0; ps = ps * r2 + 1.0;
    double pc = 1.0 / 20922789888000.0;
    pc = pc * r2 - 1.0 / 87178291200.0; pc = pc * r2 + 1.0 / 479001600.0; pc = pc * r2 - 1.0 / 3628800.0; pc = pc * r2 + 1.0 / 40320.0;
    pc = pc * r2 - 1.0 / 720.0; pc = pc * r2 + 1.0 / 24.0; pc = pc * r2 - 0.5; pc = pc * r2 + 1.0;
    s = (float)(ps * r); c = (float)(sg * pc);
}

DI void phase0(const Ptrs& P, LAS unsigned char* lds) {
    const int tid = my_tid(), lane = tid & 63, wave = tid >> 6;
    const int gw = blockIdx.x * 8 + wave, NGW = gridDim.x * 8;
    const int gt = blockIdx.x * 512 + tid, NGT = gridDim.x * 512;
    unsigned char* ws = P.ws;
    { float* sq = (float*)(ws + WS_SSQ); for (int i = gt; i < 6 * T; i += NGT) sq[i] = 0.f; }
    { f32x2* cs = (f32x2*)(ws + WS_CS);
      for (int i = gt; i < T * 32; i += NGT) { const int t = i >> 5, f = i & 31; double fr = 1.0; for (int k = 0; k < f; ++k) fr *= 0.7498942093324559;
          float c, s; sincos_d((double)P.pos[t] * fr, c, s); cs[i] = (f32x2){c, s}; } }
    { bf16_t* pb = (bf16_t*)(ws + WS_PB);
      for (int i = gt; i < T * PLE / 8; i += NGT) { const f32x4 a = *(const f32x4*)(P.p + (size_t)i * 8), b = *(const f32x4*)(P.p + (size_t)i * 8 + 4); *(u32x4*)(pb + (size_t)i * 8) = pack8(a, b); } }
    { bf16_t* h = (bf16_t*)(ws + WS_R0);
      for (int row = gw; row < T; row += NGW) {
          const f32x4* xr = (const f32x4*)(P.x + (size_t)row * D) + lane;
          f32x4 v[16]; float s = 0.f;
#pragma unroll
          for (int j = 0; j < 16; ++j) { v[j] = xr[64 * j]; s += (v[j][0] * v[j][0] + v[j][1] * v[j][1]) + (v[j][2] * v[j][2] + v[j][3] * v[j][3]); }
          const float rs = rsqrtf(wave_sum(s) * (1.0f / D) + EPS);
          u32x2* o = (u32x2*)(h + (size_t)row * D) + lane;
          const f32x4* gr = (const f32x4*)P.g_attn_pre + lane;
          f32x4 gv[16];
#pragma unroll
          for (int j = 0; j < 16; ++j) gv[j] = gr[64 * j];
#pragma unroll
          for (int j = 0; j < 16; ++j) { const f32x4 g = gv[j]; u32x2 w; w.x = pk2(v[j][0] * rs * g[0], v[j][1] * rs * g[1]); w.y = pk2(v[j][2] * rs * g[2], v[j][3] * rs * g[3]); o[64 * j] = w; }
      } }
    { LAS float* scr = (LAS float*)(lds + wave * 16640);
      for (int it = gw; it < IT_TOTAL; it += NGW) conv_item(P, it, scr, lane); }
}

DI void kr_phase(const Ptrs& P) {
    unsigned char* ws = P.ws; const float* krp = (const float*)(ws + WS_KRP); const f32x2* cs = (const f32x2*)(ws + WS_CS); bf16_t* k192 = (bf16_t*)(ws + WS_KN);
    const int tid = my_tid(), gt = blockIdx.x * 512 + tid, NGT = gridDim.x * 512;
    for (int idx = gt; idx < T * 8; idx += NGT) {
        const int row = idx >> 3, c0 = (idx & 7) * 8;
        f32x4 v0 = {0.f, 0.f, 0.f, 0.f}, v1 = {0.f, 0.f, 0.f, 0.f};
#pragma unroll
        for (int kq = 0; kq < 4; ++kq) { const float* p = krp + ((size_t)kq * T + row) * 64 + c0; v0 += *(const f32x4*)p; v1 += *(const f32x4*)(p + 4); }
        rope8(v0, v1, cs + (size_t)row * 32 + (c0 >> 1));
        const u32x4 pv = pack8(v0, v1);
        bf16_t* kp = k192 + (size_t)row * 3072 + 128 + c0;
#pragma unroll
        for (int hd = 0; hd < 16; ++hd) *(u32x4*)(kp + hd * 192) = pv;
    }
}

#define MFMA32(a, b, c) __builtin_amdgcn_mfma_f32_32x32x16_bf16((a), (b), (c), 0, 0, 0)
DI bf16x8 packp(const f32x16& x, int s) {
    u32x4 p; p.x = pk2(x[8 * s], x[8 * s + 1]); p.y = pk2(x[8 * s + 2], x[8 * s + 3]); p.z = pk2(x[8 * s + 4], x[8 * s + 5]); p.w = pk2(x[8 * s + 6], x[8 * s + 7]);
    return __builtin_bit_cast(bf16x8, p);
}
DI f32x16 zero16() { f32x16 z;
#pragma unroll
    for (int i = 0; i < 16; ++i) z[i] = 0.f;
    return z; }

DI void mla_phase(const Ptrs& P, LAS unsigned char* lds, float* ssqbase) {
    unsigned char* ws = P.ws;
    const bf16_t* q = (const bf16_t*)(ws + WS_Q); const unsigned char* k192 = ws + WS_KN;
    const unsigned char* vt = ws + WS_VT; bf16_t* mixed = (bf16_t*)(ws + WS_R0); float* ssqA = ssqbase + 2 * T;
    const int tid = my_tid(), lane = tid & 63, w = __builtin_amdgcn_readfirstlane(tid >> 6), qi = lane & 31, g = lane >> 5;
    constexpr int KBYTES = 64 * 384, BUF = KBYTES + 128 * 128;
    const float NINF = -__builtin_inff();
    unsigned koff[3], voff[2];
#pragma unroll
    for (int i = 0; i < 3; ++i) { const int u = 64 * (w * 3 + i) + lane, row = u / 24, pos = u % 24, ch = (pos & ~7) | ((pos & 7) ^ ((row >> 1) & 7)); koff[i] = (unsigned)(row * 6144 + ch * 16); }
#pragma unroll
    for (int i = 0; i < 2; ++i) { const int u = 64 * (w * 2 + i) + lane, d = u >> 3, pos = u & 7, ch = pos ^ ((d >> 1) & 7); voff[i] = (unsigned)(d * (VPITCH * 2) + ch * 16); }
    int kaddr[4], vaddr[4];
    { const int pr = pi32(qi), swk = (pr >> 1) & 7, swv = (qi >> 1) & 7;
#pragma unroll
      for (int j = 0; j < 4; ++j) { kaddr[j] = pr * 384 + 16 * ((2 * j + g) ^ swk); vaddr[j] = KBYTES + qi * 128 + 16 * ((2 * j + g) ^ swv); } }
    const unsigned ldsbase = (unsigned)(size_t)lds;
#define MLA_DMA(kt, bufoff) do { const unsigned char* _kb = uni_ptr(kbase + (size_t)(kt) * (64 * 6144)); const unsigned char* _vb = uni_ptr(vbase + (size_t)(kt) * 128); const unsigned _l = ldsbase + (unsigned)(bufoff); \
        _Pragma("unroll") for (int _i = 0; _i < 3; ++_i) dma16(_kb, koff[_i], _l + (unsigned)((w * 3 + _i) * 1024)); \
        _Pragma("unroll") for (int _i = 0; _i < 2; ++_i) dma16(_vb, voff[_i], _l + (unsigned)(KBYTES + (w * 2 + _i) * 1024)); } while (0)
    for (int uu0 = blockIdx.x; uu0 < 1024 * (PROBE_PH == 31 ? PROBE_N : 1); uu0 += gridDim.x) {
        const int uu = uu0 & 1023;
        const int kk = uu >> 8, c = uu & 255, bh = c & 31, jj = c >> 5;
        const int qb = kk == 0 ? 31 - jj : kk == 1 ? 16 + jj : kk == 2 ? 15 - jj : jj;
        const int b = bh >> 4, h = bh & 15;
        const int r0 = qb * 256 + w * 32;
        const unsigned char* kbase = k192 + ((size_t)(b * S) * 16 + h) * 384;
        const unsigned char* vbase = vt + (size_t)(bh * 128) * (VPITCH * 2);
        const int nkt = 4 * (qb + 1);
        MLA_DMA(0, 0); MLA_DMA(1, BUF);
        bf16x8 qf[12];
        { const bf16_t* qrow = q + (size_t)(b * S + r0 + qi) * QW;
#pragma unroll
          for (int ks = 0; ks < 8; ++ks) qf[ks] = *(const bf16x8*)(qrow + h * 128 + ks * 16 + g * 8);
#pragma unroll
          for (int ks = 0; ks < 4; ++ks) qf[8 + ks] = *(const bf16x8*)(qrow + 2048 + h * 64 + ks * 16 + g * 8); }
        f32x16 oacc[4];
#pragma unroll
        for (int i = 0; i < 4; ++i) oacc[i] = zero16();
        float m_run = NINF, l_run = 0.f;
#pragma unroll
        for (int ks = 0; ks < 12; ++ks) asm volatile("" :: "v"(qf[ks]));
        asm volatile("s_waitcnt vmcnt(0)" ::: "memory"); __syncthreads();
#define MLA_QK(KA, IMM, sacc_) do { \
        bf16x8 fa[4], fb[4]; \
        _Pragma("unroll") for (int j = 0; j < 4; ++j) fa[j] = *(const LAS bf16x8*)(lds + KA[j] + (IMM)); \
        _Pragma("unroll") for (int j = 0; j < 4; ++j) fb[j] = *(const LAS bf16x8*)(lds + KA[j] + (IMM) + 128); \
        __builtin_amdgcn_sched_barrier(0); \
        __builtin_amdgcn_s_setprio(1); \
        _Pragma("unroll") for (int gi = 0; gi < 6; gi += 2) { \
            _Pragma("unroll") for (int j = 0; j < 4; ++j) sacc_[gi / 3] = MFMA32(fa[j], qf[4 * (gi % 3) + j], sacc_[gi / 3]); \
            if (gi + 2 < 6) { _Pragma("unroll") for (int j = 0; j < 4; ++j) fa[j] = *(const LAS bf16x8*)(lds + KA[j] + (IMM) + 128 * ((gi + 2) % 3) + 12288 * ((gi + 2) / 3)); } \
            __builtin_amdgcn_sched_barrier(0); \
            _Pragma("unroll") for (int j = 0; j < 4; ++j) sacc_[(gi + 1) / 3] = MFMA32(fb[j], qf[4 * ((gi + 1) % 3) + j], sacc_[(gi + 1) / 3]); \
            if (gi + 3 < 6) { _Pragma("unroll") for (int j = 0; j < 4; ++j) fb[j] = *(const LAS bf16x8*)(lds + KA[j] + (IMM) + 128 * ((gi + 3) % 3) + 12288 * ((gi + 3) / 3)); } \
            __builtin_amdgcn_sched_barrier(0); \
        } \
        __builtin_amdgcn_s_setprio(0); } while (0)
#define MLA_SMPV(VA, IMM, sacc_, kt_) do { \
        if (64 * (kt_) + 63 > r0) { \
            const int qrow = r0 + qi; \
            _Pragma("unroll") for (int kb = 0; kb < 2; ++kb) \
            _Pragma("unroll") for (int e = 0; e < 16; ++e) { const int key = 64 * (kt_) + kb * 32 + 16 * (e >> 3) + 8 * g + (e & 7); if (key > qrow) sacc_[kb][e] = NINF; } \
        } \
        float mx = NINF; \
        _Pragma("unroll") for (int kb = 0; kb < 2; ++kb) \
        _Pragma("unroll") for (int e = 0; e < 16; ++e) mx = fmaxf(mx, sacc_[kb][e]); \
        mx = xhalf_max(mx); \
          \
          \
        float alpha = 1.0f; \
        if (__builtin_amdgcn_ballot_w64((mx - m_run) > 8.0f) != 0ull) { \
            const float m_new = fmaxf(m_run, mx); \
            alpha = fast_exp2(m_run - m_new); \
            m_run = m_new; \
            _Pragma("unroll") for (int db = 0; db < 4; ++db) \
            _Pragma("unroll") for (int e = 0; e < 16; ++e) oacc[db][e] *= alpha; \
        } \
        float ls0 = 0.f, ls1 = 0.f, ls2 = 0.f, ls3 = 0.f;        \
        _Pragma("unroll") for (int kb = 0; kb < 2; ++kb) \
        _Pragma("unroll") for (int e = 0; e < 16; ++e) { const float p = fast_exp2(sacc_[kb][e] - m_run); sacc_[kb][e] = p; \
            if ((e & 3) == 0) ls0 += p; else if ((e & 3) == 1) ls1 += p; else if ((e & 3) == 2) ls2 += p; else ls3 += p; } \
        l_run = l_run * alpha + ((ls0 + ls1) + (ls2 + ls3)); \
        _Pragma("unroll") for (int kb = 0; kb < 2; ++kb) \
        _Pragma("unroll") for (int s2 = 0; s2 < 2; ++s2) { \
            const bf16x8 pf = packp(sacc_[kb], s2); \
            _Pragma("unroll") for (int db = 0; db < 4; ++db) oacc[db] = MFMA32(*(const LAS bf16x8*)(lds + VA[kb * 2 + s2] + (IMM) + 4096 * db), pf, oacc[db]); \
        } } while (0)
#define MLA_INTERVAL(KA, VA, kp_, NB) do { \
        { f32x16 sacc[2]; sacc[0] = zero16(); sacc[1] = zero16(); \
          if (64 * (kp_) <= r0) { MLA_QK(KA, 0, sacc); MLA_SMPV(VA, 0, sacc, (kp_)); } } \
        if ((kp_) + 2 < nkt) { MLA_DMA((kp_) + 2, (NB)); MLA_DMA((kp_) + 3, (NB) + BUF); } \
        { f32x16 sacc[2]; sacc[0] = zero16(); sacc[1] = zero16(); \
          if (64 * ((kp_) + 1) <= r0) { MLA_QK(KA, BUF, sacc); MLA_SMPV(VA, BUF, sacc, (kp_) + 1); } } \
        asm volatile("s_waitcnt vmcnt(0)" ::: "memory"); __syncthreads(); } while (0)
        int kaddrH[4], vaddrH[4];
#pragma unroll
        for (int j = 0; j < 4; ++j) { kaddrH[j] = kaddr[j] + 2 * BUF; vaddrH[j] = vaddr[j] + 2 * BUF; }
#pragma unroll 1
        for (int kp = 0; kp < nkt; kp += 4) {
            MLA_INTERVAL(kaddr, vaddr, kp, 2 * BUF);
            MLA_INTERVAL(kaddrH, vaddrH, kp + 2, 0);
        }
#undef MLA_QK
#undef MLA_SMPV
#undef MLA_INTERVAL
        const float l = l_run + __shfl_xor(l_run, 32);
        const float inv = 1.0f / l;
        float sq = 0.f;
        bf16_t* orow = mixed + (size_t)(b * S + r0 + qi) * D + h * 128 + 8 * g;
#pragma unroll
        for (int db = 0; db < 4; ++db)
#pragma unroll
            for (int t2 = 0; t2 < 2; ++t2) {
                unsigned wa[2], wb[2];
#pragma unroll
                for (int q2 = 0; q2 < 2; ++q2) {
                    const int j4 = 2 * t2 + q2;
                    const float o0 = oacc[db][4 * j4] * inv, o1 = oacc[db][4 * j4 + 1] * inv, o2 = oacc[db][4 * j4 + 2] * inv, o3 = oacc[db][4 * j4 + 3] * inv;
                    sq += (o0 * o0 + o1 * o1) + (o2 * o2 + o3 * o3);
                    if (q2 == 0) { wa[0] = pk2(o0, o1); wa[1] = pk2(o2, o3); } else { wb[0] = pk2(o0, o1); wb[1] = pk2(o2, o3); }
                }
                const auto rx = __builtin_amdgcn_permlane32_swap(wa[0], wb[0], false, false);
                const auto ry = __builtin_amdgcn_permlane32_swap(wa[1], wb[1], false, false);
                u32x4 wv; wv.x = rx[0]; wv.y = ry[0]; wv.z = rx[1]; wv.w = ry[1];
                *(u32x4*)(orow + 32 * db + 16 * t2) = wv;
            }
        sq += __shfl_xor(sq, 32);
        if (g == 0) unsafeAtomicAdd(ssqA + (uu0 >= 1024 ? 6 * T : 0) + b * S + r0 + qi, sq);
    }
#undef MLA_DMA
}

DI void swa_phase(const Ptrs& P, LAS unsigned char* lds, float* ssqbase) {
    unsigned char* ws = P.ws;
    const bf16_t* proj = (const bf16_t*)(ws + WS_PROJ); const bf16_t* vts = (const bf16_t*)(ws + WS_VTS);
    bf16_t* mixed = (bf16_t*)(ws + WS_R0); float* ssqB = ssqbase + 3 * T;
    const int tid = my_tid(), lane = tid & 63, w = __builtin_amdgcn_readfirstlane(tid >> 6), qi = lane & 31, g = lane >> 5;
    constexpr int KST = 144, VST = 528, KBYTES = 256 * KST, VBYTES = 64 * VST;
    LAS float* POS = (LAS float*)(lds + KBYTES + VBYTES);
    const float NINF = -__builtin_inff();
    for (int uu0 = blockIdx.x; uu0 < 2048 * (PROBE_PH == 32 ? PROBE_N : 1); uu0 += gridDim.x) {
        const int uu = uu0 & 2047;
        const int hp = uu & 3, gk = (uu >> 2) & 3, n = (uu >> 4) & 63, b = uu >> 10;
        const int key_base = (n - 1) * 128;
        __syncthreads();
#pragma unroll
        for (int i = 0; i < 4; ++i) {
            const int id = tid + 512 * i;
            { const int kl = id >> 3, ch = id & 7, key = key_base + kl, keyc = key < 0 ? 0 : key;
              u32x4 v = *(const u32x4*)(proj + (size_t)(b * S + keyc) * DIN_P + PJ_KS + gk * 64 + ch * 8);
              if (key < 0) v = (u32x4){0u, 0u, 0u, 0u};
              *(LAS u32x4*)(lds + kl * KST + ch * 16) = v; }
            { const int d = id >> 5, ch = id & 31, key = key_base + ch * 8, keyc = key < 0 ? 0 : key;
              u32x4 v = *(const u32x4*)(vts + (size_t)((b * 4 + gk) * 64 + d) * VPITCH + keyc);
              if (key < 0) v = (u32x4){0u, 0u, 0u, 0u};
              *(LAS u32x4*)(lds + KBYTES + d * VST + ch * 16) = v; }
        }
        if (tid < 256) { const int key = key_base + tid, keyc = key < 0 ? 0 : key; const float pv = (float)P.pos[b * S + keyc]; POS[tid] = key >= 0 ? pv : 0.f; }
        __syncthreads();
        const int head = gk * 8 + hp * 2 + (w >> 2), wq = w & 3, qoff = wq * 32;
        const int trow = b * S + n * 128 + qoff + qi;
        bf16x8 qf[4];
#pragma unroll
        for (int ks = 0; ks < 4; ++ks) qf[ks] = *(const bf16x8*)(proj + (size_t)trow * DIN_P + PJ_QS + head * 64 + ks * 16 + g * 8);
        const float posq = (float)P.pos[trow];
        const float slope2 = fast_exp2(-0.25f * (float)(head + 1)) * LOG2E;
        const float sink2 = P.sinks[head] * LOG2E;
        f32x16 sacc[5];
#pragma unroll
        for (int t = 0; t < 5; ++t) {
            const int kb = wq + t;
            const LAS unsigned char* kp = lds + (kb * 32 + pi32(qi)) * KST + g * 16;
            f32x16 a = zero16();
#pragma unroll
            for (int ks = 0; ks < 4; ++ks) a = MFMA32(*(const LAS bf16x8*)(kp + ks * 32), qf[ks], a);
            sacc[t] = a;
            __builtin_amdgcn_sched_barrier(0);
        }
        float mx = sink2;
#pragma unroll
        for (int t = 0; t < 5; ++t) {
            const int kb = wq + t;
            const bool padblk = (n == 0) && (kb < 4);
#pragma unroll
            for (int hh = 0; hh < 2; ++hh) {
                const int kl0 = kb * 32 + 16 * hh + 8 * g;
                const f32x4 pa = *(const LAS f32x4*)(POS + kl0), pb = *(const LAS f32x4*)(POS + kl0 + 4);
#pragma unroll
                for (int e = 0; e < 8; ++e) {
                    const int kll = 16 * hh + 8 * g + e;
                    const float pk = e < 4 ? pa[e & 3] : pb[e & 3];
                    float sv = sacc[t][8 * hh + e] - slope2 * fabsf(posq - pk);
                    bool valid = !padblk;
                    if (t == 0) valid = valid && (kll > qi);
                    if (t == 4) valid = valid && (kll <= qi);
                    sv = valid ? sv : NINF;
                    sacc[t][8 * hh + e] = sv; mx = fmaxf(mx, sv);
                }
            }
        }
        mx = xhalf_max(mx);
        float lsum = 0.f;
#pragma unroll
        for (int t = 0; t < 5; ++t)
#pragma unroll
            for (int e = 0; e < 16; ++e) { const float p = fast_exp2(sacc[t][e] - mx); sacc[t][e] = p; lsum += p; }
        f32x16 oacc[2]; oacc[0] = zero16(); oacc[1] = zero16();
#pragma unroll
        for (int t = 0; t < 5; ++t) {
            const int kb = wq + t;
#pragma unroll
            for (int s2 = 0; s2 < 2; ++s2) {
                const bf16x8 pf = packp(sacc[t], s2);
#pragma unroll
                for (int db = 0; db < 2; ++db) {
                    const LAS unsigned char* vp = lds + KBYTES + (32 * db + qi) * VST + (kb * 32 + 16 * s2 + 8 * g) * 2;
                    oacc[db] = MFMA32(*(const LAS bf16x8*)vp, pf, oacc[db]);
                }
                __builtin_amdgcn_sched_barrier(0);
            }
        }
        const float l = lsum + __shfl_xor(lsum, 32) + fast_exp2(sink2 - mx);
        const float inv = 1.0f / l;
        float sq = 0.f;
        bf16_t* orow = mixed + (size_t)trow * D + 2048 + head * 64 + 4 * g;
#pragma unroll
        for (int db = 0; db < 2; ++db)
#pragma unroll
            for (int j4 = 0; j4 < 4; ++j4) {
                const float o0 = oacc[db][4 * j4] * inv, o1 = oacc[db][4 * j4 + 1] * inv, o2 = oacc[db][4 * j4 + 2] * inv, o3 = oacc[db][4 * j4 + 3] * inv;
                sq += (o0 * o0 + o1 * o1) + (o2 * o2 + o3 * o3);
                u32x2 wv; wv.x = pk2(o0, o1); wv.y = pk2(o2, o3);
                *(u32x2*)(orow + 32 * db + 8 * j4) = wv;
            }
        sq += __shfl_xor(sq, 32);
        if (g == 0) unsafeAtomicAdd(ssqB + (uu0 >= 2048 ? 6 * T : 0) + trow, sq);
    }
}

DI void norm_mixed_phase(const Ptrs& P) {
    unsigned char* ws = P.ws; bf16_t* mixed = (bf16_t*)(ws + WS_R0);
    const float* ssqA = (const float*)(ws + WS_SSQ) + 2 * T; const float* ssqB = ssqA + T;
    const int tid = my_tid(), lane = tid & 63, gw = blockIdx.x * 8 + (tid >> 6), NGW = gridDim.x * 8;
    for (int row = gw; row < T; row += NGW) {
        const float rsA = rsqrtf(ssqA[row] * (1.0f / 2048.0f) + EPS), rsB = rsqrtf(ssqB[row] * (1.0f / 2048.0f) + EPS);
        u32x4* mp = (u32x4*)(mixed + (size_t)row * D) + lane;
#pragma unroll
        for (int j = 0; j < 8; ++j) {
            const int col0 = (lane + 64 * j) * 8; const bool hb = col0 >= 2048;
            const float rs = hb ? rsB : rsA; const float* gp = hb ? P.g_swa + (col0 - 2048) : P.g_mla + col0;
            const f32x4 g0 = *(const f32x4*)gp, g1 = *(const f32x4*)(gp + 4);
            const u32x4 v = mp[64 * j]; u32x4 o;
            o.x = pk2(bflo(v.x) * rs * g0[0], bfhi(v.x) * rs * g0[1]); o.y = pk2(bflo(v.y) * rs * g0[2], bfhi(v.y) * rs * g0[3]);
            o.z = pk2(bflo(v.z) * rs * g1[0], bfhi(v.z) * rs * g1[1]); o.w = pk2(bflo(v.w) * rs * g1[2], bfhi(v.w) * rs * g1[3]);
            mp[64 * j] = o;
        }
    }
}
DI void x1_phase(const Ptrs& P) {
    unsigned char* ws = P.ws; const bf16_t* y = (const bf16_t*)(ws + WS_Y); const float* ssq_y = (const float*)(ws + WS_SSQ) + 4 * T; bf16_t* h2 = (bf16_t*)(ws + WS_R0);
    const int tid = my_tid(), lane = tid & 63, gw = blockIdx.x * 8 + (tid >> 6), NGW = gridDim.x * 8;
    for (int row = gw; row < T; row += NGW) {
        const float rsy = rsqrtf(ssq_y[row] * (1.0f / D) + EPS);
        const f32x4* xr = (const f32x4*)(P.x + (size_t)row * D) + lane; const u32x2* yr = (const u32x2*)(y + (size_t)row * D) + lane;
        const f32x4* gp = (const f32x4*)P.g_attn_post + lane; u32x2* op = (u32x2*)((bf16_t*)P.out + (size_t)row * D) + lane;
        f32x4 v[16]; float s = 0.f;
#pragma unroll
        for (int hb = 0; hb < 2; ++hb) {
            f32x4 a[8], gg[8]; u32x2 yb[8];
#pragma unroll
            for (int j = 0; j < 8; ++j) { a[j] = xr[64 * (8 * hb + j)]; gg[j] = gp[64 * (8 * hb + j)]; yb[j] = yr[64 * (8 * hb + j)]; }
#pragma unroll
            for (int j = 0; j < 8; ++j) { const f32x4 bq = {bflo(yb[j].x), bfhi(yb[j].x), bflo(yb[j].y), bfhi(yb[j].y)};
                const f32x4 r = a[j] + bq * rsy * gg[j]; v[8 * hb + j] = r; u32x2 xb; xb.x = pk2(r[0], r[1]); xb.y = pk2(r[2], r[3]); op[64 * (8 * hb + j)] = xb;
                s += (r[0] * r[0] + r[1] * r[1]) + (r[2] * r[2] + r[3] * r[3]); }
        }
        const f32x4* g2 = (const f32x4*)P.g_ffn_pre + lane;
        f32x4 g2v[16];
#pragma unroll
        for (int j = 0; j < 16; ++j) g2v[j] = g2[64 * j];
        const float rs = rsqrtf(wave_sum(s) * (1.0f / D) + EPS);
        u32x2* o = (u32x2*)(h2 + (size_t)row * D) + lane;
#pragma unroll
        for (int j = 0; j < 16; ++j) { const f32x4 gg = g2v[j]; u32x2 wv; wv.x = pk2(v[j][0] * rs * gg[0], v[j][1] * rs * gg[1]); wv.y = pk2(v[j][2] * rs * gg[2], v[j][3] * rs * gg[3]); o[64 * j] = wv; }
    }
}
DI void x2_phase(const Ptrs& P) {
    unsigned char* ws = P.ws; const bf16_t* f = (const bf16_t*)(ws + WS_F); const float* ssq_f = (const float*)(ws + WS_SSQ) + 5 * T; bf16_t* x2b = (bf16_t*)(ws + WS_X2B);
    const int tid = my_tid(), lane = tid & 63, gw = blockIdx.x * 8 + (tid >> 6), NGW = gridDim.x * 8;
    for (int row = gw; row < T; row += NGW) {
        const float rsf = rsqrtf(ssq_f[row] * (1.0f / D) + EPS);
        const u32x2* fr = (const u32x2*)(f + (size_t)row * D) + lane; const f32x4* gp = (const f32x4*)P.g_ffn_post + lane;
        const u32x2* op = (const u32x2*)((const bf16_t*)P.out + (size_t)row * D) + lane; u32x2* o = (u32x2*)(x2b + (size_t)row * D) + lane;
        u32x2 abv[16], fbv[16]; f32x4 ggv[16];
#pragma unroll
        for (int j = 0; j < 16; ++j) { abv[j] = op[64 * j]; fbv[j] = fr[64 * j]; ggv[j] = gp[64 * j]; }
#pragma unroll
        for (int j = 0; j < 16; ++j) { const u32x2 ab = abv[j]; const f32x4 a = {bflo(ab.x), bfhi(ab.x), bflo(ab.y), bfhi(ab.y)}, gg = ggv[j]; const u32x2 fb = fbv[j]; const f32x4 bq = {bflo(fb.x), bfhi(fb.x), bflo(fb.y), bfhi(fb.y)};
            const f32x4 r = a + bq * rsf * gg;
            u32x2 wv; wv.x = pk2(r[0], r[1]); wv.y = pk2(r[2], r[3]); o[64 * j] = wv; }
    }
}

constexpr int NPHASE = 11;
struct Params { const void* in[21]; float* out; unsigned char* ws; int ph_lo, ph_hi; };

__global__ void __launch_bounds__(512, 2) mk_fwd(Params prm) {
    extern __shared__ __attribute__((aligned(16))) unsigned char lds_raw[];
    LAS unsigned char* lds = (LAS unsigned char*)lds_raw;
#define GPTR(T, i) ((T*)(T __attribute__((address_space(1)))*)kin[i])
#define LOADP() Ptrs P; { const void* kin[23]; _Pragma("unroll") for (int _q = 0; _q < 21; ++_q) kin[_q] = prm.in[_q]; kin[21] = prm.out; kin[22] = prm.ws; \
    P.x = GPTR(const float, 0); P.p = GPTR(const float, 1); P.pos = GPTR(const int, 2); P.g_attn_pre = GPTR(const float, 3); P.w_in = GPTR(const float, 4); \
    P.g_qa = GPTR(const float, 5); P.w_qup = GPTR(const float, 6); P.g_kva = GPTR(const float, 7); P.w_kvup = GPTR(const float, 8); P.sinks = GPTR(const float, 9); \
    P.g_mla = GPTR(const float, 10); P.g_swa = GPTR(const float, 11); P.w_o = GPTR(const float, 12); P.g_attn_post = GPTR(const float, 13); P.g_ffn_pre = GPTR(const float, 14); \
    P.w_gate = GPTR(const float, 15); P.w_up = GPTR(const float, 16); P.w_down = GPTR(const float, 17); P.g_ffn_post = GPTR(const float, 18); \
    P.w_pg = GPTR(const float, 19); P.w_pp = GPTR(const float, 20); P.out = GPTR(float, 21); P.ws = GPTR(unsigned char, 22); \
 } \
    unsigned char* ws = P.ws; float* ssq = (float*)(ws + WS_SSQ); const f32x2* cs = (const f32x2*)(ws + WS_CS); (void)ssq; (void)cs;
    const int lo = prm.ph_lo, hi = prm.ph_hi;
    const int G = gridDim.x, cid = blockIdx.x;
    if (hi - lo > 1) xcd_barrier_post((unsigned*)(prm.ws + WS_KR));
    if (hi > 1000) cg::this_grid().sync();
#define IN(k) (lo <= (k) && (k) < hi)
#define SEAM(k) do { if (IN((k) + 1)) xcd_barrier((unsigned*)(ws + WS_KR)); } while (0)
#define NREP(k) ((PROBE_PH == (k) || (PROBE_PH >= 10 && PROBE_PH / 10 == (k))) ? PROBE_N : 1)
#define REPSYNC(k) do { if (_r + 1 < NREP(k)) cg::this_grid().sync(); } while (0)
    if (IN(0)) { LOADP(); phase0(P, lds); if (PROBE_PH == 0) { cg::this_grid().sync(); phase0(P, lds); } SEAM(0); }
    if (IN(1)) { LOADP();
        for (int _r = 0; _r < NREP(1); ++_r) {
        float* sq = ssq + (_r ? 6 * T : 0);
        { pg8::Gemm g{(const bf16_t*)(ws + WS_R0), (const bf16_t*)(ws + WS_WIN), T, 3840, D, D, D}; pg8::StaticOrder So; So.init(T, 3840, G, cid);
          EpiIn E{(bf16_t*)(ws + WS_PROJ), sq, sq + T, (bf16_t*)(ws + WS_VTS), (bf16_t*)(ws + WS_KN), cs};
          pg8::gemm_phase<EpiIn>(lds, g, So, E); }
        {
            const int t0 = (64 * 15) % G, gp = t0 ? G - t0 : G, cp = t0 ? cid - t0 : cid;
            if (cp >= 0) {
                pg8::Gemm g{(const bf16_t*)(ws + WS_WIN) + (size_t)3840 * D, (const bf16_t*)(ws + WS_R0), 256, T, D, D, D}; pg8::StaticOrder So; So.init(256, T, gp, cp);
                EpiVt E{(bf16_t*)(ws + WS_VTS), 256, nullptr, 0.f};
                pg8::gemm_phase<EpiVt>(lds, g, So, E);
            }
        }
        { pg8::Gemm g{(const bf16_t*)(ws + WS_R0), (const bf16_t*)(ws + WS_WIN) + (size_t)4096 * D, T, 256, 1024, D, D}; pg8::StaticOrder So; So.init(T, 256, G, cid, 2);
          EpiKr E{(float*)(ws + WS_KRP)};
          pg8::gemm_phase<EpiKr>(lds, g, So, E); }
        REPSYNC(1); }
        SEAM(1);
    }
    if (IN(2)) { LOADP();
        kr_phase(P);
        for (int _r = 0; _r < NREP(2); ++_r) {
        { pg8::Gemm g{(const bf16_t*)(ws + WS_PROJ) + PJ_CQ, (const bf16_t*)(ws + WS_WQUP), T, QW, 1024, DIN_P, 1024}; pg8::StaticOrder So; So.init(T, QW, G, cid);
          EpiUp<0> E{ssq, 1.0f / 1024.0f, MLA_QSCALE, (bf16_t*)(ws + WS_Q), QW, cs, nullptr};
          pg8::gemm_phase<EpiUp<0>>(lds, g, So, E); }
        { pg8::Gemm g{(const bf16_t*)(ws + WS_PROJ) + PJ_CKV, (const bf16_t*)(ws + WS_WKVUP), T, 2048, 512, DIN_P, 512}; pg8::StaticOrder So; So.init(T, 2048, G, cid);
          EpiUp<1> E{ssq + T, 1.0f / 512.0f, 1.0f, (bf16_t*)(ws + WS_KN), KNW, cs, nullptr};
          pg8::gemm_phase<EpiUp<1>>(lds, g, So, E); }
        { pg8::Gemm g{(const bf16_t*)(ws + WS_WKVUP) + (size_t)2048 * 512, (const bf16_t*)(ws + WS_PROJ) + PJ_CKV, 2048, T, 512, 512, DIN_P}; pg8::StaticOrder So; So.init(2048, T, G, cid);
          EpiVt E{(bf16_t*)(ws + WS_VT), 2048, ssq + T, 1.0f / 512.0f};
          pg8::gemm_phase<EpiVt>(lds, g, So, E); }
        REPSYNC(2); }
        SEAM(2);
    }
    if (IN(3)) { LOADP();
        mla_phase(P, lds, ssq); swa_phase(P, lds, ssq);
        SEAM(3);
    }
    if (IN(5)) { LOADP();
        for (int _r = 0; _r < NREP(5); ++_r) {
        pg8::Gemm g{(const bf16_t*)(ws + WS_R0), (const bf16_t*)(ws + WS_WO), T, D, 2048, D, D}; pg8::StaticOrder So; So.init(T, D, G, cid, 1);
        EpiBf16Ssq<true> E{(bf16_t*)(ws + WS_Y), ssq + 4 * T + (_r ? 6 * T : 0), ssq + 2 * T, ssq + 3 * T};
        pg8::gemm_phase<EpiBf16Ssq<true>>(lds, g, So, E); REPSYNC(5); }
        SEAM(5);
    }
    if (IN(6)) { LOADP(); for (int _r = 0; _r < NREP(6); ++_r) { x1_phase(P); REPSYNC(6); } SEAM(6); }
    if (IN(7)) { LOADP();
        for (int _r = 0; _r < NREP(7); ++_r) {
        pg8::Gemm g{(const bf16_t*)(ws + WS_R0), (const bf16_t*)(ws + WS_WGU), T, 2 * DFF, D, D, D}; pg8::StaticOrder So; So.init(T, 2 * DFF, G, cid);
        EpiSwiglu E{(bf16_t*)(ws + WS_ACT)};
        pg8::gemm_phase<EpiSwiglu>(lds, g, So, E); REPSYNC(7); }
        {
            const int t0 = (64 * 86) % G, gp = t0 ? G - t0 : G, cp = t0 ? cid - t0 : cid;
            if (cp >= 0) {
                pg8::Gemm g{(const bf16_t*)(ws + WS_PB), (const bf16_t*)(ws + WS_WPP), T, D, PLE, PLE, PLE}; pg8::StaticOrder So; So.init(T, D, gp, cp);
                EpiBf16 E{(bf16_t*)(ws + WS_PP), D};
                pg8::gemm_phase<EpiBf16>(lds, g, So, E);
            }
        }
        SEAM(7);
    }
    if (IN(8)) { LOADP();
        for (int _r = 0; _r < NREP(8); ++_r) {
        pg8::Gemm g{(const bf16_t*)(ws + WS_ACT), (const bf16_t*)(ws + WS_WDN), T, D, DFF, DFF, DFF}; pg8::StaticOrder So; So.init(T, D, G, cid);
        EpiBf16Ssq<false> E{(bf16_t*)(ws + WS_F), ssq + 5 * T + (_r ? 6 * T : 0), nullptr, nullptr};
        pg8::gemm_phase<EpiBf16Ssq<false>>(lds, g, So, E); REPSYNC(8); }
        SEAM(8);
    }
    if (IN(9)) { LOADP(); x2_phase(P); SEAM(9); }
    if (IN(10)) { LOADP();
        { pg8::Gemm g{(const bf16_t*)(ws + WS_X2B), (const bf16_t*)(ws + WS_WPG), T, D, D, D, D}; pg8::StaticOrder So; So.init(T, D, G, cid);
          EpiPle E{P.out, (const bf16_t*)(ws + WS_PP), (const bf16_t*)(ws + WS_X2B)};
          pg8::gemm_phase<EpiPle>(lds, g, So, E); }
    }
#undef IN
#undef SEAM
#undef NREP
#undef REPSYNC
}

extern "C" void kernel_launch(void* const* d_in, const int* in_sizes, int n_in, void* d_out, int out_size, void* d_ws, size_t ws_size, hipStream_t stream) {
    static int grid = 0;
    if (grid == 0) {
        if (n_in != 21 || out_size != T * D || ws_size < WS_TOTAL) { fprintf(stderr, "kernel_launch: unexpected shapes (n_in %d out %d ws %zu)\n", n_in, out_size, ws_size); grid = -1; return; }
        int dev = 0, cus = 0, per_cu = 0;
        hipGetDevice(&dev);
        hipDeviceGetAttribute(&cus, hipDeviceAttributeMultiprocessorCount, dev);
        if (hipFuncSetAttribute((const void*)mk_fwd, hipFuncAttributeMaxDynamicSharedMemorySize, LDS_BYTES) != hipSuccess) { fprintf(stderr, "kernel_launch: hipFuncSetAttribute failed\n"); grid = -1; return; }
        if (hipOccupancyMaxActiveBlocksPerMultiprocessor(&per_cu, (const void*)mk_fwd, 512, LDS_BYTES) != hipSuccess || per_cu < 1) { fprintf(stderr, "kernel_launch: occupancy query says %d\n", per_cu); per_cu = 1; }
        (void)hipGetLastError();
        grid = cus * 1;
        if (grid <= 0) grid = 256;
    }
    if (grid < 0) return;
    Params a{};
    for (int i = 0; i < 21; ++i) a.in[i] = d_in[i];
    a.out = (float*)d_out; a.ws = (unsigned char*)d_ws;
#if MK_SINGLE
    if (hipMemsetAsync((char*)d_ws + WS_KR, 0, 16384, stream) != hipSuccess) { fprintf(stderr, "kernel_launch: hipMemsetAsync failed\n"); return; }
    a.ph_lo = 0; a.ph_hi = NPHASE;
    void* args[] = {&a};
    hipError_t e = hipLaunchCooperativeKernel((const void*)mk_fwd, dim3(grid), dim3(512), args, LDS_BYTES, stream);
    if (e != hipSuccess) fprintf(stderr, "cooperative launch failed: %s (grid %d)\n", hipGetErrorString(e), grid);
#else
    for (int ph = 0; ph < NPHASE; ++ph) {
        a.ph_lo = ph; a.ph_hi = ph + 1;
        hipLaunchKernelGGL(mk_fwd, dim3(grid), dim3(512), LDS_BYTES, stream, a);
    }
#endif
}
```

```cpp
#include <hip/hip_runtime.h>
#include <hip/hip_cooperative_groups.h>
#include <cstdio>
#include <cstdint>
namespace cg = cooperative_groups;

#ifndef PROBE_PH
#define PROBE_PH -1
#define PROBE_N 1
#endif
#ifndef MK_SINGLE
#define MK_SINGLE 1
#endif

#define DI __device__ __forceinline__
#define LAS __attribute__((address_space(3)))
typedef unsigned short bf16_t;
typedef short bf16x8 __attribute__((ext_vector_type(8)));
typedef float f32x4 __attribute__((ext_vector_type(4)));
typedef float f32x2 __attribute__((ext_vector_type(2)));
typedef float f32x16 __attribute__((ext_vector_type(16)));
typedef unsigned u32x4 __attribute__((ext_vector_type(4)));
typedef unsigned u32x2 __attribute__((ext_vector_type(2)));
typedef __bf16 bf16x2_t __attribute__((ext_vector_type(2)));

constexpr int NB = 2, S = 8192, T = NB * S, D = 4096, DFF = 11008, PLE = 256;
constexpr int DIN_P = 4352;
constexpr int QW = 3072, KNW = 2048;
constexpr float EPS = 1e-6f;
constexpr float LOG2E = 1.4426950408889634f;
constexpr float MLA_QSCALE = 0.10411754627697264f;
constexpr float SWA_QSCALE = 0.18033688011112042f;
constexpr int LDS_BYTES = 163840;
constexpr int VPITCH = S + 128;

constexpr int PJ_CQ = 0, PJ_CKV = 1024, PJ_QS = 1536, PJ_KS = 3584, PJ_VS = 3840, PJ_KR = 4096;

constexpr size_t al256(size_t x) { return (x + 255) & ~(size_t)255; }
constexpr size_t WS_WIN = 0;
constexpr size_t WS_WQUP = WS_WIN + (size_t)DIN_P * D * 2;
constexpr size_t WS_WKVUP = WS_WQUP + (size_t)QW * 1024 * 2;
constexpr size_t WS_WO = WS_WKVUP + (size_t)4096 * 512 * 2;
constexpr size_t WS_WGU = WS_WO + (size_t)D * D * 2;
constexpr size_t WS_WDN = WS_WGU + (size_t)2 * DFF * D * 2;
constexpr size_t WS_WPG = WS_WDN + (size_t)D * DFF * 2;
constexpr size_t WS_WPP = WS_WPG + (size_t)D * D * 2;
constexpr size_t WS_CS = WS_WPP + (size_t)D * PLE * 2;
constexpr size_t WS_SSQ = WS_CS + (size_t)T * 32 * 8;
constexpr size_t WS_PB = WS_SSQ + (size_t)12 * T * 4;
constexpr size_t WS_KR = WS_PB + (size_t)T * PLE * 2;
constexpr size_t WS_KRP = WS_KR + 16384;
constexpr size_t WS_VTS = WS_KRP + (size_t)4 * T * 64 * 4;
constexpr size_t WS_R0 = al256(WS_VTS + (size_t)NB * 4 * 64 * VPITCH * 2);
constexpr size_t WS_B = WS_R0 + (size_t)T * D * 2;
constexpr size_t WS_PROJ = WS_B;
constexpr size_t WS_Q = WS_PROJ + (size_t)T * DIN_P * 2;
constexpr size_t WS_KN = WS_Q + (size_t)T * QW * 2;
constexpr size_t WS_VT = WS_KN + (size_t)T * 3072 * 2;
constexpr size_t WS_VT_END = WS_VT + (size_t)NB * 2048 * VPITCH * 2;
constexpr size_t WS_Y = WS_B;
constexpr size_t WS_TOTAL = (size_t)1 << 30;
constexpr size_t WS_ACT = WS_TOTAL - (size_t)T * DFF * 2;
constexpr size_t WS_F = WS_R0;
constexpr size_t WS_X2B = WS_ACT;
constexpr size_t WS_PP = WS_B;
static_assert(WS_VT_END <= WS_TOTAL, "ws");
static_assert(WS_Y + (size_t)T * D * 4 <= WS_TOTAL, "ws");
static_assert(WS_F + (size_t)T * D * 4 <= WS_ACT, "ws");
static_assert(WS_R0 + (size_t)T * D * 2 <= WS_ACT, "ws");
static_assert(WS_PP + (size_t)T * D * 2 <= WS_ACT, "ws");

DI unsigned pk2(float a, float b) { f32x2 v = {a, b}; return __builtin_bit_cast(unsigned, __builtin_convertvector(v, bf16x2_t)); }
DI bf16_t f2bf(float a) { return (bf16_t)(pk2(a, 0.f) & 0xffffu); }
DI float bflo(unsigned u) { return __uint_as_float(u << 16); }
DI float bfhi(unsigned u) { return __uint_as_float(u & 0xffff0000u); }
DI float wave_sum(float v) {
#pragma unroll
    for (int o = 1; o < 64; o <<= 1) v += __shfl_xor(v, o);
    return v;
}
DI float fast_exp2(float x) { return __builtin_amdgcn_exp2f(x); }
DI float fast_rcp(float x) { return __builtin_amdgcn_rcpf(x); }
DI float sigmoidf_(float v) { return fast_rcp(1.0f + fast_exp2(-v * LOG2E)); }
DI int my_tid() { int t = threadIdx.x; asm volatile("" : "+v"(t)); return t; }
DI float xhalf_max(float v) { const auto r = __builtin_amdgcn_permlane32_swap(__float_as_uint(v), __float_as_uint(v), false, false); return fmaxf(__uint_as_float(r[0]), __uint_as_float(r[1])); }
DI const unsigned char* uni_ptr(const unsigned char* p) { const unsigned long long v = (unsigned long long)p; const unsigned lo = __builtin_amdgcn_readfirstlane((unsigned)v), hi = __builtin_amdgcn_readfirstlane((unsigned)(v >> 32)); return (const unsigned char*)(((unsigned long long)hi << 32) | lo); }
DI void dma16(const unsigned char* sbase, unsigned voff, unsigned ldsaddr) { asm volatile("s_mov_b32 m0, %0\n\ts_nop 0\n\tglobal_load_lds_dwordx4 %1, %2" :: "s"(ldsaddr), "v"(voff), "s"(sbase) : "memory"); }
DI int pi32(int i) { return (i & ~12) | ((i & 4) << 1) | ((i & 8) >> 1); }


#define XB_TMO      128
#define XB_XCNT(j)  (256  + 64 * (j))
#define XB_XSUB(j)  (1280 + 64 * (j))
#define XB_XGEN(j)  (2304 + 64 * (j))
#define XB_TOP      3328
#define XB_TOPGEN   3392
#define XB_SLOT(w)  (3456 + 2 * (w))
#define XB_WORDS    4096
#define XB_SPIN_CAP (1u << 20)
DI unsigned xb_ld(unsigned* p) { return __hip_atomic_load(p, __ATOMIC_RELAXED, __HIP_MEMORY_SCOPE_AGENT); }
DI unsigned xb_add(unsigned* p, unsigned v) { return __hip_atomic_fetch_add(p, v, __ATOMIC_RELAXED, __HIP_MEMORY_SCOPE_AGENT); }
DI unsigned xb_xcc_id() { return (unsigned)__builtin_amdgcn_s_getreg((3 << 11) | 20) & 0xFu; }
#define XB_SPIN(cond, bar) do { unsigned _sp = 0; while (cond) { __builtin_amdgcn_s_sleep(1); \
    if ((++_sp & 255u) == 0u) { if (xb_ld(&(bar)[XB_TMO])) break; if (_sp > XB_SPIN_CAP) { xb_add(&(bar)[XB_TMO], 1u); break; } } } } while (0)
DI void xcd_barrier_post(unsigned* bar) { if (threadIdx.x == 0) (void)xb_add(&bar[XB_XCNT(xb_xcc_id())], 1u); }
DI void xcd_barrier(unsigned* bar) {
    asm volatile("s_waitcnt vmcnt(0) lgkmcnt(0)" ::: "memory");
    __syncthreads();
    if (threadIdx.x == 0) {
        const unsigned x = xb_xcc_id(), G = gridDim.x;
        unsigned nloc = xb_ld(&bar[XB_SLOT(blockIdx.x)]), nx = xb_ld(&bar[XB_SLOT(blockIdx.x) + 1]);
        if (nloc == 0u) {
            unsigned sum, cnt, mine, sp = 0u;
            for (;;) {
                sum = 0u; cnt = 0u; mine = 0u;
#pragma unroll
                for (unsigned j = 0; j < 16; ++j) { const unsigned c = xb_ld(&bar[XB_XCNT(j)]); sum += c; cnt += (c > 0u) ? 1u : 0u; mine = (j == x) ? c : mine; }
                if (sum == G) break;
                __builtin_amdgcn_s_sleep(1);
                if ((++sp & 255u) == 0u) { if (xb_ld(&bar[XB_TMO])) break; if (sp > XB_SPIN_CAP) { xb_add(&bar[XB_TMO], 1u); break; } }
            }
            nloc = mine > 0u ? mine : 1u; nx = cnt > 0u ? cnt : 1u;
            __hip_atomic_store(&bar[XB_SLOT(blockIdx.x)], nloc, __ATOMIC_RELAXED, __HIP_MEMORY_SCOPE_AGENT); __hip_atomic_store(&bar[XB_SLOT(blockIdx.x) + 1], nx, __ATOMIC_RELAXED, __HIP_MEMORY_SCOPE_AGENT);
        }
        const unsigned old = xb_add(&bar[XB_XSUB(x)], 1u);
        const unsigned gen = old / nloc;
        if (old + 1u == (gen + 1u) * nloc) {
            __builtin_amdgcn_fence(__ATOMIC_RELEASE, "agent");
            asm volatile("s_waitcnt vmcnt(0)" ::: "memory");
            const unsigned og = xb_add(&bar[XB_TOP], 1u);
            const unsigned tg = og / nx;
            if (og + 1u == (tg + 1u) * nx) xb_add(&bar[XB_TOPGEN], 1u);
            else XB_SPIN(xb_ld(&bar[XB_TOPGEN]) == tg, bar);
            __builtin_amdgcn_fence(__ATOMIC_ACQUIRE, "agent");
            xb_add(&bar[XB_XGEN(x)], 1u);
            asm volatile("s_waitcnt vmcnt(0)" ::: "memory");
        } else {
            XB_SPIN(xb_ld(&bar[XB_XGEN(x)]) == gen, bar);
            __builtin_amdgcn_fence(__ATOMIC_ACQUIRE, "agent");
            asm volatile("s_waitcnt vmcnt(0)" ::: "memory");
        }
    }
    __syncthreads();
}

namespace pg8 {
constexpr int BM = 256, BK = 64, HALF = 128, HTB = HALF * BK * 2, STAGE_BYTES = 8 * HTB, NXCD = 8, WGM = 8;
DI int lds_byte(int r, int c) { const int st = (r >> 4) * 2 + (c >> 5), rr = r & 15, cc = c & 31, ob = rr * 64 + cc * 2; return st * 1024 + (ob ^ (((ob >> 9) & 1) << 5)); }
DI void stage_rc(int b, int& R, int& C) { const int st = b / 1024, sb = b % 1024, swz = sb ^ (((sb >> 9) & 1) << 5); R = (st >> 1) * 16 + swz / 64; C = (st & 1) * 32 + (swz % 64) / 2; }
DI int perm32(int rho) { const int n = rho >> 4, i = rho & 15; return 8 * (i >> 2) + 4 * n + (i & 3); }

struct Unit { int pm, pn, half; };
struct Gemm { const bf16_t* A; const bf16_t* Bt; int M, N, K, lda, ldb; };

struct StaticOrder {
    int nM, nN, nwg, G, c, split;
    DI void init(int M, int N, int G_, int c_, int split_ = 0) { nM = M / BM; nN = N / BM; nwg = nM * nN; G = G_; c = c_; split = split_; }
    DI bool next(int i, Unit& u) const {
        if (split == 2) { const long L4 = (long)i * G + c; if (L4 >= 4L * nM) return false; u.pm = (int)(L4 >> 2); u.pn = 0; u.half = (int)(L4 & 3); return true; }
        u.half = split ? (i & 1) : 1; if (split) i >>= 1;
        const long L = (long)i * G + c; if (L >= nwg) return false;
        int wgid = (int)L; { const int q = nwg / NXCD, r = nwg % NXCD, xcd = wgid % NXCD, off = wgid / NXCD; wgid = (xcd < r ? xcd * (q + 1) : r * (q + 1) + (xcd - r) * q) + off; }
        const int nig = WGM * nN, gid = wgid / nig, fm = gid * WGM, gsz = (nM - fm) < WGM ? (nM - fm) : WGM;
        u.pm = fm + ((wgid % nig) % gsz); u.pn = (wgid % nig) / gsz; return true;
    }
};

template <class Epi>
DI void gemm_phase(LAS unsigned char* lds, const Gemm g, const StaticOrder& S, const Epi& E) {
    const int tid = my_tid(), wid = __builtin_amdgcn_readfirstlane(tid >> 6), lane = tid & 63, wr = wid >> 2, wc = wid & 3, fr = lane & 15, fq = lane >> 4;
    int K = g.K; asm volatile("" : "+s"(K));
    const int nt = K / BK;
    unsigned voffA[2], voffB[2];
#pragma unroll
    for (int i = 0; i < 2; ++i) { int R, C; stage_rc(tid * 16 + i * 8192, R, C); const int Rb = Epi::PERM ? ((R & ~31) + perm32(R & 31)) : R;
        voffA[i] = (unsigned)(R * g.lda + C) * 2u; voffB[i] = (unsigned)(Rb * g.ldb + C) * 2u; }
    const size_t kstep = (size_t)(BK * 2);
    const size_t hstepA = (size_t)HALF * g.lda * 2, hstepB = (size_t)HALF * g.ldb * 2;
    const size_t tstepA = 2 * hstepA, tstepB = 2 * hstepB;
    const unsigned ldsw = (unsigned)wid * 1024u;
    const int aoff = lds_byte(wr * 64 + fr, fq * 8), boff = lds_byte(wc * 32 + fr, fq * 8);
#define PG8_SA(b, h) (((b) * 2 + (h)) * HTB)
#define PG8_SB(b, h) ((4 + (b) * 2 + (h)) * HTB)
#define PG8_STAGE(bufoff, gbase, voff) do { _Pragma("unroll") for (int _i = 0; _i < 2; ++_i) \
        __builtin_amdgcn_global_load_lds((const unsigned*)((const char*)(gbase) + (voff)[_i]), (LAS unsigned*)(lds + (bufoff) + ldsw + _i * 8192), 16, 0, 0); } while (0)
#define PG8_LDA(dst, b, h) do { _Pragma("unroll") for (int m = 0; m < 4; ++m) _Pragma("unroll") for (int k = 0; k < 2; ++k) dst[m][k] = *(const LAS bf16x8*)(lds + PG8_SA(b, h) + aoff + m * 2048 + k * 1024); } while (0)
#define PG8_LDB(dst, b, h) do { _Pragma("unroll") for (int n = 0; n < 2; ++n) _Pragma("unroll") for (int k = 0; k < 2; ++k) dst[n][k] = *(const LAS bf16x8*)(lds + PG8_SB(b, h) + boff + n * 2048 + k * 1024); } while (0)
#define PG8_MMA(ai, bj, At, Bt) do { __builtin_amdgcn_s_setprio(1); _Pragma("unroll") for (int m = 0; m < 4; ++m) _Pragma("unroll") for (int n = 0; n < 2; ++n) _Pragma("unroll") for (int k = 0; k < 2; ++k) \
        acc[ai][bj][m][n] = __builtin_amdgcn_mfma_f32_16x16x32_bf16(Bt[n][k], At[m][k], acc[ai][bj][m][n], 0, 0, 0); __builtin_amdgcn_s_setprio(0); } while (0)
#define PG8_WAIT_V(n) asm volatile("s_waitcnt vmcnt(" #n ")" ::: "memory")
#define PG8_WAIT_L(n) asm volatile("s_waitcnt lgkmcnt(" #n ")" ::: "memory")
#define PG8_BAR __builtin_amdgcn_s_barrier()
#define PG8_SCHED __builtin_amdgcn_sched_barrier(0)
    Unit cur, nxt; int ui = 0;
    if (!S.next(0, cur)) return;
    f32x4 acc[2][2][4][2];
#pragma unroll
    for (int a = 0; a < 2; ++a)
#pragma unroll
        for (int b = 0; b < 2; ++b)
#pragma unroll
            for (int m = 0; m < 4; ++m)
#pragma unroll
                for (int n = 0; n < 2; ++n) acc[a][b][m][n] = (f32x4){0.f, 0.f, 0.f, 0.f};
    bf16x8 At[4][2], B0[2][2], B1[2][2];
#define PG8_KOFF(u) ((Epi::MIDK || Epi::KSPLIT) ? (size_t)(u).half * (size_t)K * 2 : (size_t)0)
    const char* cA = (const char*)g.A + (size_t)cur.pm * tstepA + PG8_KOFF(cur); const char* cB = (const char*)g.Bt + (size_t)cur.pn * tstepB + PG8_KOFF(cur);
    PG8_STAGE(PG8_SB(0, 0), cB, voffB); PG8_STAGE(PG8_SB(0, 1), cB + hstepB, voffB); PG8_STAGE(PG8_SA(0, 0), cA, voffA); PG8_STAGE(PG8_SA(0, 1), cA + hstepA, voffA);
    if (wr == 1) PG8_BAR;
    PG8_WAIT_V(2); PG8_BAR;
    PG8_STAGE(PG8_SB(1, 0), cB + kstep, voffB); PG8_STAGE(PG8_SA(1, 0), cA + kstep, voffA); PG8_STAGE(PG8_SB(1, 1), cB + hstepB + kstep, voffB);
    PG8_WAIT_V(6); PG8_BAR;
    for (;;) {
        const bool has_next = S.next(ui + 1, nxt);
        const char* nA = has_next ? (const char*)g.A + (size_t)nxt.pm * tstepA + PG8_KOFF(nxt) : cA; const char* nB = has_next ? (const char*)g.Bt + (size_t)nxt.pn * tstepB + PG8_KOFF(nxt) : cB;
        for (int t = 0; t < nt; t += 2) {
            const bool last = (t == nt - 2);
            const char* a1 = cA + (size_t)(t + 1) * kstep;
            const char* a2 = last ? nA : cA + (size_t)(t + 2) * kstep; const char* b2 = last ? nB : cB + (size_t)(t + 2) * kstep;
            const char* a3 = a2 + kstep; const char* b3 = b2 + kstep;
            PG8_LDB(B0, 0, 0); PG8_LDB(B1, 0, 1); PG8_SCHED; PG8_LDA(At, 0, 0); PG8_STAGE(PG8_SA(1, 1), a1 + hstepA, voffA);
            PG8_WAIT_V(8); PG8_WAIT_L(0); PG8_BAR; PG8_MMA(0, 0, At, B0); PG8_MMA(0, 1, At, B1); PG8_BAR; PG8_SCHED;
            PG8_LDA(At, 0, 1); PG8_STAGE(PG8_SB(0, 0), b2, voffB); PG8_STAGE(PG8_SB(0, 1), b2 + hstepB, voffB); PG8_STAGE(PG8_SA(0, 0), a2, voffA);
            PG8_WAIT_V(8); PG8_WAIT_L(0); PG8_BAR; PG8_MMA(1, 0, At, B0); PG8_MMA(1, 1, At, B1); PG8_BAR; PG8_SCHED;
            PG8_LDB(B0, 1, 0); PG8_LDB(B1, 1, 1); PG8_SCHED; PG8_LDA(At, 1, 0); PG8_STAGE(PG8_SA(0, 1), a2 + hstepA, voffA);
            PG8_WAIT_V(8); PG8_WAIT_L(0); PG8_BAR; PG8_MMA(0, 0, At, B0); PG8_MMA(0, 1, At, B1); PG8_BAR; PG8_SCHED;
            PG8_LDA(At, 1, 1); PG8_STAGE(PG8_SB(1, 0), b3, voffB); PG8_STAGE(PG8_SB(1, 1), b3 + hstepB, voffB); PG8_STAGE(PG8_SA(1, 0), a3, voffA);
            PG8_WAIT_V(8); PG8_WAIT_L(0); PG8_BAR; PG8_MMA(1, 0, At, B0); PG8_MMA(1, 1, At, B1); PG8_BAR; PG8_SCHED;
        }
        if (wr == 0) PG8_BAR;
        bool keep = false;
        if constexpr (Epi::MIDK) { if (cur.half == 0) { E.mid(acc, cur, wr, wc, fr, fq); keep = true; } else E(acc, cur, wr, wc, fr, fq); } else E(acc, cur, wr, wc, fr, fq);
        if (!has_next) break;
        if (!keep)
#pragma unroll
        for (int a = 0; a < 2; ++a)
#pragma unroll
            for (int b = 0; b < 2; ++b)
#pragma unroll
                for (int m = 0; m < 4; ++m)
#pragma unroll
                    for (int n = 0; n < 2; ++n) acc[a][b][m][n] = (f32x4){0.f, 0.f, 0.f, 0.f};
        cur = nxt; cA = nA; cB = nB; ++ui;
        if (wr == 1) PG8_BAR;
    }
    PG8_WAIT_V(0);
    PG8_BAR;
#undef PG8_SA
#undef PG8_KOFF
#undef PG8_SB
#undef PG8_STAGE
#undef PG8_LDA
#undef PG8_LDB
#undef PG8_MMA
#undef PG8_WAIT_V
#undef PG8_WAIT_L
#undef PG8_BAR
#undef PG8_SCHED
}
}
using pg8::Unit;

typedef const f32x4 (&AccRef)[2][2][4][2];

DI float row_sq(AccRef acc, int ai, int m) {
    float s = 0.f;
#pragma unroll
    for (int bj = 0; bj < 2; ++bj)
#pragma unroll
        for (int n = 0; n < 2; ++n) { const f32x4 v = acc[ai][bj][m][n]; s += (v[0] * v[0] + v[1] * v[1]) + (v[2] * v[2] + v[3] * v[3]); }
    s += __shfl_xor(s, 16); s += __shfl_xor(s, 32);
    return s;
}
DI u32x4 pack8(f32x4 v0, f32x4 v1) { u32x4 w; w.x = pk2(v0[0], v0[1]); w.y = pk2(v0[2], v0[3]); w.z = pk2(v1[0], v1[1]); w.w = pk2(v1[2], v1[3]); return w; }
DI void rope8(f32x4& v0, f32x4& v1, const f32x2* cs) {
    const f32x4 c01 = *(const f32x4*)cs, c23 = *(const f32x4*)(cs + 2);
    f32x4 r0, r1;
    r0[0] = v0[0] * c01[0] - v0[1] * c01[1]; r0[1] = v0[0] * c01[1] + v0[1] * c01[0];
    r0[2] = v0[2] * c01[2] - v0[3] * c01[3]; r0[3] = v0[2] * c01[3] + v0[3] * c01[2];
    r1[0] = v1[0] * c23[0] - v1[1] * c23[1]; r1[1] = v1[0] * c23[1] + v1[1] * c23[0];
    r1[2] = v1[2] * c23[2] - v1[3] * c23[3]; r1[3] = v1[2] * c23[3] + v1[3] * c23[2];
    v0 = r0; v1 = r1;
}

struct EpiIn {
    static constexpr bool PERM = true, MIDK = false, KSPLIT = false;
    bf16_t* proj; float* ssq_q; float* ssq_kv; bf16_t* vts; bf16_t* kr; const f32x2* cs;
    DI void operator()(AccRef acc, const Unit& u, int wr, int wc, int fr, int fq) const {
        const int row0 = u.pm * 256 + wr * 64 + fr, colt = u.pn * 256, lc0 = wc * 32 + 8 * fq;
#pragma unroll
        for (int ai = 0; ai < 2; ++ai)
#pragma unroll
            for (int m = 0; m < 4; ++m) {
                const int row = row0 + ai * 128 + m * 16;
                bf16_t* rp = proj + (size_t)row * DIN_P + colt + lc0;
#pragma unroll
                for (int bj = 0; bj < 2; ++bj) *(u32x4*)(rp + bj * 128) = pack8(acc[ai][bj][m][0], acc[ai][bj][m][1]);
            }
        if (u.pn < 6) {
            float* sq = u.pn < 4 ? ssq_q : ssq_kv;
#pragma unroll
            for (int ai = 0; ai < 2; ++ai)
#pragma unroll
                for (int m = 0; m < 4; ++m) { const float s = row_sq(acc, ai, m); if (fq == 0) unsafeAtomicAdd(sq + row0 + ai * 128 + m * 16, s); }
        }
    }
};

struct EpiKr {
    static constexpr bool PERM = true, MIDK = false, KSPLIT = true;
    float* krp;
    DI void operator()(AccRef acc, const Unit& u, int wr, int wc, int fr, int fq) const {
        if (wc >= 2) return;
        const int row0 = u.pm * 256 + wr * 64 + fr, lc0 = wc * 32 + 8 * fq;
#pragma unroll
        for (int ai = 0; ai < 2; ++ai)
#pragma unroll
            for (int m = 0; m < 4; ++m) {
                float* rp = krp + ((size_t)u.half * T + row0 + ai * 128 + m * 16) * 64 + lc0;
                *(f32x4*)rp = acc[ai][0][m][0]; *(f32x4*)(rp + 4) = acc[ai][0][m][1];
            }
    }
};

struct EpiVt {
    static constexpr bool PERM = true, MIDK = false, KSPLIT = false;
    bf16_t* out; int rows_per_batch; const float* ssq; float inv_dim;
    DI void operator()(AccRef acc, const Unit& u, int wr, int wc, int fr, int fq) const {
        const int n0 = u.pm * 256 + wr * 64 + fr, t0 = u.pn * 256 + wc * 32 + 8 * fq, b = t0 >> 13, s0 = t0 & (S - 1);
        f32x4 sc[2][2];
#pragma unroll
        for (int bj = 0; bj < 2; ++bj)
#pragma unroll
            for (int n = 0; n < 2; ++n) {
                if (ssq) { const f32x4 q = *(const f32x4*)(ssq + t0 + bj * 128 + 4 * n);
#pragma unroll
                    for (int j = 0; j < 4; ++j) sc[bj][n][j] = rsqrtf(q[j] * inv_dim + EPS);
                } else sc[bj][n] = (f32x4){1.f, 1.f, 1.f, 1.f};
            }
#pragma unroll
        for (int ai = 0; ai < 2; ++ai)
#pragma unroll
            for (int m = 0; m < 4; ++m) {
                bf16_t* rp = out + ((size_t)(b * rows_per_batch + n0 + ai * 128 + m * 16)) * VPITCH + s0;
#pragma unroll
                for (int bj = 0; bj < 2; ++bj) *(u32x4*)(rp + bj * 128) = pack8(acc[ai][bj][m][0] * sc[bj][0], acc[ai][bj][m][1] * sc[bj][1]);
            }
    }
};

template <int MODE> struct EpiUp {
    static constexpr bool PERM = true, MIDK = false, KSPLIT = false;
    const float* ssq; float inv_dim, mul; bf16_t* out; int ldc; const f32x2* cs; bf16_t* vt;
    template <bool ROPE> DI void run(AccRef acc, const Unit& u, int wr, int wc, int fr, int fq) const {
        const int row0 = u.pm * 256 + wr * 64 + fr, colt = u.pn * 256, lc0 = wc * 32 + 8 * fq;
        float sc[2][4];
#pragma unroll
        for (int ai = 0; ai < 2; ++ai)
#pragma unroll
            for (int m = 0; m < 4; ++m) sc[ai][m] = ssq[row0 + ai * 128 + m * 16];
#pragma unroll
        for (int ai = 0; ai < 2; ++ai) {
            f32x4 c01[4], c23[4];
            if (ROPE) {
#pragma unroll
                for (int m = 0; m < 4; ++m) { const f32x2* cp = cs + (size_t)(row0 + ai * 128 + m * 16) * 32 + (wc & 1) * 16 + 4 * fq; c01[m] = *(const f32x4*)cp; c23[m] = *(const f32x4*)(cp + 2); }
            }
#pragma unroll
            for (int m = 0; m < 4; ++m) {
                const int row = row0 + ai * 128 + m * 16;
                const float scl = rsqrtf(sc[ai][m] * inv_dim + EPS) * mul;
#pragma unroll
                for (int bj = 0; bj < 2; ++bj) {
                    f32x4 v0 = acc[ai][bj][m][0] * scl, v1 = acc[ai][bj][m][1] * scl;
                    if (ROPE) {
                        const f32x4 a = c01[m], bq = c23[m]; f32x4 r0, r1;
                        r0[0] = v0[0] * a[0] - v0[1] * a[1]; r0[1] = v0[0] * a[1] + v0[1] * a[0];
                        r0[2] = v0[2] * a[2] - v0[3] * a[3]; r0[3] = v0[2] * a[3] + v0[3] * a[2];
                        r1[0] = v1[0] * bq[0] - v1[1] * bq[1]; r1[1] = v1[0] * bq[1] + v1[1] * bq[0];
                        r1[2] = v1[2] * bq[2] - v1[3] * bq[3]; r1[3] = v1[2] * bq[3] + v1[3] * bq[2];
                        v0 = r0; v1 = r1;
                    }
                    if (MODE == 1) *(u32x4*)(out + (size_t)row * 3072 + (u.pn * 2 + bj) * 192 + lc0) = pack8(v0, v1);
                    else *(u32x4*)(out + (size_t)row * ldc + colt + bj * 128 + lc0) = pack8(v0, v1);
                }
            }
        }
    }
    DI void operator()(AccRef acc, const Unit& u, int wr, int wc, int fr, int fq) const {
        if (MODE == 0 && u.pn >= 8) run<true>(acc, u, wr, wc, fr, fq); else run<false>(acc, u, wr, wc, fr, fq);
    }
};

template <bool MIDK_> struct EpiBf16Ssq {
    static constexpr bool PERM = true, MIDK = MIDK_, KSPLIT = false;
    bf16_t* C; float* ssq; const float* ssqA; const float* ssqB;
    DI void mid(f32x4 (&acc)[2][2][4][2], const Unit& u, int wr, int wc, int fr, int fq) const {
        const int row0 = u.pm * 256 + wr * 64 + fr;
#pragma unroll
        for (int ai = 0; ai < 2; ++ai)
#pragma unroll
            for (int m = 0; m < 4; ++m) {
                const int row = row0 + ai * 128 + m * 16;
                const float ratio = rsqrtf(ssqA[row] * (1.0f / 2048.0f) + EPS) * sqrtf(ssqB[row] * (1.0f / 2048.0f) + EPS);
#pragma unroll
                for (int bj = 0; bj < 2; ++bj)
#pragma unroll
                    for (int n = 0; n < 2; ++n) acc[ai][bj][m][n] *= ratio;
            }
    }
    DI void operator()(AccRef acc, const Unit& u, int wr, int wc, int fr, int fq) const {
        const int row0 = u.pm * 256 + wr * 64 + fr, col0 = u.pn * 256 + wc * 32 + 8 * fq;
        float sb[2][4];
        if (MIDK) {
#pragma unroll
            for (int ai = 0; ai < 2; ++ai)
#pragma unroll
                for (int m = 0; m < 4; ++m) sb[ai][m] = ssqB[row0 + ai * 128 + m * 16];
        }
#pragma unroll
        for (int ai = 0; ai < 2; ++ai)
#pragma unroll
            for (int m = 0; m < 4; ++m) {
                const int row = row0 + ai * 128 + m * 16;
                float sc = 1.0f;
                if (MIDK) sc = rsqrtf(sb[ai][m] * (1.0f / 2048.0f) + EPS);
                bf16_t* rp = C + (size_t)row * D + col0;
#pragma unroll
                for (int bj = 0; bj < 2; ++bj) *(u32x4*)(rp + bj * 128) = pack8(acc[ai][bj][m][0] * sc, acc[ai][bj][m][1] * sc);
                const float s = row_sq(acc, ai, m) * sc * sc; if (fq == 0) unsafeAtomicAdd(ssq + row, s);
            }
    }
};

struct EpiSwiglu {
    static constexpr bool PERM = true, MIDK = false, KSPLIT = false;
    bf16_t* act;
    DI void operator()(AccRef acc, const Unit& u, int wr, int wc, int fr, int fq) const {
        const int row0 = u.pm * 256 + wr * 64 + fr, col0 = u.pn * 128 + wc * 32 + 8 * fq;
#pragma unroll
        for (int ai = 0; ai < 2; ++ai)
#pragma unroll
            for (int m = 0; m < 4; ++m) {
                const int row = row0 + ai * 128 + m * 16;
                f32x4 r[2];
#pragma unroll
                for (int n = 0; n < 2; ++n)
#pragma unroll
                    for (int j = 0; j < 4; ++j) { const float gt = acc[ai][0][m][n][j], up = acc[ai][1][m][n][j]; r[n][j] = gt * sigmoidf_(gt) * up; }
                *(u32x4*)(act + (size_t)row * DFF + col0) = pack8(r[0], r[1]);
            }
    }
};

struct EpiBf16 {
    static constexpr bool PERM = true, MIDK = false, KSPLIT = false;
    bf16_t* out; int ldc;
    DI void operator()(AccRef acc, const Unit& u, int wr, int wc, int fr, int fq) const {
        const int row0 = u.pm * 256 + wr * 64 + fr, col0 = u.pn * 256 + wc * 32 + 8 * fq;
#pragma unroll
        for (int ai = 0; ai < 2; ++ai)
#pragma unroll
            for (int m = 0; m < 4; ++m) {
                bf16_t* rp = out + (size_t)(row0 + ai * 128 + m * 16) * ldc + col0;
#pragma unroll
                for (int bj = 0; bj < 2; ++bj) *(u32x4*)(rp + bj * 128) = pack8(acc[ai][bj][m][0], acc[ai][bj][m][1]);
            }
    }
};

struct EpiPle {
    static constexpr bool PERM = true, MIDK = false, KSPLIT = false;
    float* out; const bf16_t* pp; const bf16_t* x2b;
    DI void operator()(AccRef acc, const Unit& u, int wr, int wc, int fr, int fq) const {
        const int row0 = u.pm * 256 + wr * 64 + fr, col0 = u.pn * 256 + wc * 32 + 8 * fq;
#pragma unroll
        for (int ai = 0; ai < 2; ++ai) {
            u32x4 pv[4][2], xv[4][2];
#pragma unroll
            for (int m = 0; m < 4; ++m)
#pragma unroll
                for (int bj = 0; bj < 2; ++bj) { const size_t o = (size_t)(row0 + ai * 128 + m * 16) * D + col0 + bj * 128; pv[m][bj] = *(const u32x4*)(pp + o); xv[m][bj] = *(const u32x4*)(x2b + o); }
#pragma unroll
            for (int m = 0; m < 4; ++m)
#pragma unroll
                for (int bj = 0; bj < 2; ++bj) {
                    float* op = out + (size_t)(row0 + ai * 128 + m * 16) * D + col0 + bj * 128;
                    const u32x4 p4 = pv[m][bj], x4 = xv[m][bj];
                    const f32x4 a0 = acc[ai][bj][m][0], a1 = acc[ai][bj][m][1];
                    f32x4 x0, x1;
                    x0[0] = bflo(x4.x) + sigmoidf_(a0[0]) * bflo(p4.x); x0[1] = bfhi(x4.x) + sigmoidf_(a0[1]) * bfhi(p4.x);
                    x0[2] = bflo(x4.y) + sigmoidf_(a0[2]) * bflo(p4.y); x0[3] = bfhi(x4.y) + sigmoidf_(a0[3]) * bfhi(p4.y);
                    x1[0] = bflo(x4.z) + sigmoidf_(a1[0]) * bflo(p4.z); x1[1] = bfhi(x4.z) + sigmoidf_(a1[1]) * bfhi(p4.z);
                    x1[2] = bflo(x4.w) + sigmoidf_(a1[2]) * bflo(p4.w); x1[3] = bfhi(x4.w) + sigmoidf_(a1[3]) * bfhi(p4.w);
                    *(f32x4*)op = x0; *(f32x4*)(op + 4) = x1;
                }
        }
    }
};

struct TDesc { const float* src; int N; int c0; bf16_t* dst; int ldk; int n0; int perm; const float* rowscale; float colscale; const float* rowscale_hi; };

typedef const float __attribute__((address_space(1)))* gfp_t;
typedef const f32x4 __attribute__((address_space(1)))* gf4p_t;
DI void transpose_item(const TDesc& d, int kt, LAS float* scr, int lane) {
    const int k0 = kt * 64;
    const int lr = lane >> 4, lc = (lane & 15) * 4;
    f32x4 v[16]; float rsv[16];
    const gfp_t src = (gfp_t)(d.src + (size_t)(k0 + lr) * d.N + d.c0 + lc);
#pragma unroll
    for (int i = 0; i < 16; ++i) v[i] = *(gf4p_t)(src + (size_t)(4 * i) * d.N);
    if (d.rowscale) {
        const gfp_t rsp = (gfp_t)(((d.rowscale_hi && k0 >= 2048) ? d.rowscale_hi + (k0 - 2048) : d.rowscale + k0) + lr);
#pragma unroll
        for (int i = 0; i < 16; ++i) rsv[i] = rsp[4 * i] * d.colscale;
    } else {
#pragma unroll
        for (int i = 0; i < 16; ++i) rsv[i] = d.colscale;
    }
#pragma unroll
    for (int i = 0; i < 16; ++i) {
        LAS float* sp = scr + (4 * i + lr) * 65 + lc;
        sp[0] = v[i][0] * rsv[i]; sp[1] = v[i][1] * rsv[i]; sp[2] = v[i][2] * rsv[i]; sp[3] = v[i][3] * rsv[i];
    }
    asm volatile("s_waitcnt lgkmcnt(0)" ::: "memory");
    const int c = lane & 7;
#pragma unroll
    for (int j = 0; j < 8; ++j) {
        const int n = (lane >> 3) + 8 * j;
        const int sn = d.perm ? ((n >> 1) + 32 * (n & 1)) : n;
        const LAS float* s = scr + (8 * c) * 65 + sn;
        u32x4 o; o.x = pk2(s[0], s[65]); o.y = pk2(s[130], s[195]); o.z = pk2(s[260], s[325]); o.w = pk2(s[390], s[455]);
        *(u32x4 __attribute__((address_space(1)))*)(d.dst + (size_t)(d.n0 + n) * d.ldk + k0 + 8 * c) = o;
    }
    asm volatile("s_waitcnt lgkmcnt(0)" ::: "memory");
}

struct Ptrs {
    const float *x, *p; const int* pos; const float *g_attn_pre, *w_in, *g_qa, *w_qup, *g_kva, *w_kvup, *sinks, *g_mla, *g_swa, *w_o, *g_attn_post, *g_ffn_pre,
        *w_gate, *w_up, *w_down, *g_ffn_post, *w_pg, *w_pp;
    float* out; unsigned char* ws;
};

constexpr int IT_IN = 65 * 64, IT_QUP = 48 * 16, IT_KVUP = 64 * 8, IT_O = 64 * 64, IT_GU = 344 * 64, IT_DN = 64 * 172, IT_PG = 64 * 64, IT_PP = 64 * 4;
constexpr int IT_TOTAL = IT_IN + IT_QUP + IT_KVUP + IT_O + IT_GU + IT_DN + IT_PG + IT_PP;

DI void conv_item(const Ptrs& P, int it, LAS float* scr, int lane) {
    TDesc d; int kt; d.perm = 0; d.rowscale = nullptr; d.colscale = 1.0f; d.rowscale_hi = nullptr;
    unsigned char* ws = P.ws;
    if (it < IT_IN) { const int jt = it % 65; kt = it / 65; d.src = P.w_in; d.N = 4160; d.dst = (bf16_t*)(ws + WS_WIN); d.ldk = D; d.n0 = jt * 64;
        if (jt < 24) d.c0 = 64 * jt; else if (jt < 56) { d.c0 = 1600 + 64 * (jt - 24); d.colscale = SWA_QSCALE; } else if (jt < 64) d.c0 = 3648 + 64 * (jt - 56); else { d.c0 = 1536; d.perm = 1; }
    } else if ((it -= IT_IN) < IT_QUP) { const int jt = it % 48; kt = it / 48; d.src = P.w_qup; d.N = 3072; d.dst = (bf16_t*)(ws + WS_WQUP); d.ldk = 1024; d.n0 = jt * 64; d.rowscale = P.g_qa;
        if (jt < 32) d.c0 = (jt >> 1) * 192 + 64 * (jt & 1); else { d.c0 = (jt - 32) * 192 + 128; d.perm = 1; }
    } else if ((it -= IT_QUP) < IT_KVUP) { const int jt = it % 64; kt = it / 64; d.src = P.w_kvup; d.N = 4096; d.dst = (bf16_t*)(ws + WS_WKVUP); d.ldk = 512; d.n0 = jt * 64; d.rowscale = P.g_kva;
        if (jt < 32) d.c0 = (jt >> 1) * 256 + 64 * (jt & 1); else d.c0 = ((jt - 32) >> 1) * 256 + 128 + 64 * (jt & 1);
    } else if ((it -= IT_KVUP) < IT_O) { const int jt = it % 64; kt = it / 64; d.src = P.w_o; d.N = D; d.dst = (bf16_t*)(ws + WS_WO); d.ldk = D; d.n0 = jt * 64; d.c0 = jt * 64; d.rowscale = P.g_mla; d.rowscale_hi = P.g_swa;
    } else if ((it -= IT_O) < IT_GU) { const int jt = it % 344; kt = it / 344; const int t = jt >> 2, sub = jt & 3; d.src = sub < 2 ? P.w_gate : P.w_up; d.N = DFF; d.dst = (bf16_t*)(ws + WS_WGU); d.ldk = D; d.n0 = jt * 64;
        d.c0 = 128 * t + 64 * (sub & 1);
    } else if ((it -= IT_GU) < IT_DN) { const int jt = it % 64; kt = it / 64; d.src = P.w_down; d.N = D; d.dst = (bf16_t*)(ws + WS_WDN); d.ldk = DFF; d.n0 = jt * 64; d.c0 = jt * 64;
    } else if ((it -= IT_DN) < IT_PG) { const int jt = it % 64; kt = it / 64; d.src = P.w_pg; d.N = D; d.dst = (bf16_t*)(ws + WS_WPG); d.ldk = D; d.n0 = jt * 64; d.c0 = jt * 64;
    } else { it -= IT_PG; const int jt = it % 64; kt = it / 64; d.src = P.w_pp; d.N = D; d.dst = (bf16_t*)(ws + WS_WPP); d.ldk = PLE; d.n0 = jt * 64; d.c0 = jt * 64; }
    transpose_item(d, kt, scr, lane);
}

DI void sincos_d(double a, float& c, float& s) {
    const double n = __builtin_rint(a * 0.15915494309189535);
    double r = __builtin_fma(-n, 6.283185307179586, a);
    r = __builtin_fma(-n, 2.4492935982947064e-16, r);
    double sg = 1.0;
    if (r > 1.5707963267948966) { r = 3.141592653589793 - r; sg = -1.0; }
    else if (r < -1.5707963267948966) { r = -3.141592653589793 - r; sg = -1.0; }
    const double r2 = r * r;
    double ps = -1.0 / 1307674368000.0;
    ps = ps * r2 + 1.0 / 6227020800.0; ps = ps * r2 - 1.0 / 39916800.0; ps = ps * r2 + 1.0 / 362880.0; ps = ps * r2 - 1.0 / 5040.0;
    ps = ps * r2 + 1.0 / 120.0; ps = ps * r2 - 1.0 / 6.0; ps = ps * r2 + 1.0;
    double pc = 1.0 / 20922789888000.0;
    pc = pc * r2 - 1.0 / 87178291200.0; pc = pc * r2 + 1.0 / 479001600.0; pc = pc * r2 - 1.0 / 3628800.0; pc = pc * r2 + 1.0 / 40320.0;
    pc = pc * r2 - 1.0 / 720.0; pc = pc * r2 + 1.0 / 24.0; pc = pc * r2 - 0.5; pc = pc * r2 + 1.0;
    s = (float)(ps * r); c = (float)(sg * pc);
}

DI void phase0(const Ptrs& P, LAS unsigned char* lds) {
    const int tid = my_tid(), lane = tid & 63, wave = tid >> 6;
    const int gw = blockIdx.x * 8 + wave, NGW = gridDim.x * 8;
    const int gt = blockIdx.x * 512 + tid, NGT = gridDim.x * 512;
    unsigned char* ws = P.ws;
    { float* sq = (float*)(ws + WS_SSQ); for (int i = gt; i < 6 * T; i += NGT) sq[i] = 0.f; }
    { f32x2* cs = (f32x2*)(ws + WS_CS);
      for (int i = gt; i < T * 32; i += NGT) { const int t = i >> 5, f = i & 31; double fr = 1.0; for (int k = 0; k < f; ++k) fr *= 0.7498942093324559;
          float c, s; sincos_d((double)P.pos[t] * fr, c, s); cs[i] = (f32x2){c, s}; } }
    { bf16_t* pb = (bf16_t*)(ws + WS_PB);
      for (int i = gt; i < T * PLE / 8; i += NGT) { const f32x4 a = *(const f32x4*)(P.p + (size_t)i * 8), b = *(const f32x4*)(P.p + (size_t)i * 8 + 4); *(u32x4*)(pb + (size_t)i * 8) = pack8(a, b); } }
    { bf16_t* h = (bf16_t*)(ws + WS_R0);
      for (int row = gw; row < T; row += NGW) {
          const f32x4* xr = (const f32x4*)(P.x + (size_t)row * D) + lane;
          f32x4 v[16]; float s = 0.f;
#pragma unroll
          for (int j = 0; j < 16; ++j) { v[j] = xr[64 * j]; s += (v[j][0] * v[j][0] + v[j][1] * v[j][1]) + (v[j][2] * v[j][2] + v[j][3] * v[j][3]); }
          const float rs = rsqrtf(wave_sum(s) * (1.0f / D) + EPS);
          u32x2* o = (u32x2*)(h + (size_t)row * D) + lane;
          const f32x4* gr = (const f32x4*)P.g_attn_pre + lane;
          f32x4 gv[16];
#pragma unroll
          for (int j = 0; j < 16; ++j) gv[j] = gr[64 * j];
#pragma unroll
          for (int j = 0; j < 16; ++j) { const f32x4 g = gv[j]; u32x2 w; w.x = pk2(v[j][0] * rs * g[0], v[j][1] * rs * g[1]); w.y = pk2(v[j][2] * rs * g[2], v[j][3] * rs * g[3]); o[64 * j] = w; }
      } }
    { LAS float* scr = (LAS float*)(lds + wave * 16640);
      for (int it = gw; it < IT_TOTAL; it += NGW) conv_item(P, it, scr, lane); }
}

DI void kr_phase(const Ptrs& P) {
    unsigned char* ws = P.ws; const float* krp = (const float*)(ws + WS_KRP); const f32x2* cs = (const f32x2*)(ws + WS_CS); bf16_t* k192 = (bf16_t*)(ws + WS_KN);
    const int tid = my_tid(), gt = blockIdx.x * 512 + tid, NGT = gridDim.x * 512;
    for (int idx = gt; idx < T * 8; idx += NGT) {
        const int row = idx >> 3, c0 = (idx & 7) * 8;
        f32x4 v0 = {0.f, 0.f, 0.f, 0.f}, v1 = {0.f, 0.f, 0.f, 0.f};
#pragma unroll
        for (int kq = 0; kq < 4; ++kq) { const float* p = krp + ((size_t)kq * T + row) * 64 + c0; v0 += *(const f32x4*)p; v1 += *(const f32x4*)(p + 4); }
        rope8(v0, v1, cs + (size_t)row * 32 + (c0 >> 1));
        const u32x4 pv = pack8(v0, v1);
        bf16_t* kp = k192 + (size_t)row * 3072 + 128 + c0;
#pragma unroll
        for (int hd = 0; hd < 16; ++hd) *(u32x4*)(kp + hd * 192) = pv;
    }
}

#define MFMA32(a, b, c) __builtin_amdgcn_mfma_f32_32x32x16_bf16((a), (b), (c), 0, 0, 0)
DI bf16x8 packp(const f32x16& x, int s) {
    u32x4 p; p.x = pk2(x[8 * s], x[8 * s + 1]); p.y = pk2(x[8 * s + 2], x[8 * s + 3]); p.z = pk2(x[8 * s + 4], x[8 * s + 5]); p.w = pk2(x[8 * s + 6], x[8 * s + 7]);
    return __builtin_bit_cast(bf16x8, p);
}
DI f32x16 zero16() { f32x16 z;
#pragma unroll
    for (int i = 0; i < 16; ++i) z[i] = 0.f;
    return z; }

DI void mla_phase(const Ptrs& P, LAS unsigned char* lds, float* ssqbase) {
    unsigned char* ws = P.ws;
    const bf16_t* q = (const bf16_t*)(ws + WS_Q); const unsigned char* k192 = ws + WS_KN;
    const unsigned char* vt = ws + WS_VT; bf16_t* mixed = (bf16_t*)(ws + WS_R0); float* ssqA = ssqbase + 2 * T;
    const int tid = my_tid(), lane = tid & 63, w = __builtin_amdgcn_readfirstlane(tid >> 6), qi = lane & 31, g = lane >> 5;
    constexpr int KBYTES = 64 * 384, BUF = KBYTES + 128 * 128;
    const float NINF = -__builtin_inff();
    unsigned koff[3], voff[2];
#pragma unroll
    for (int i = 0; i < 3; ++i) { const int u = 64 * (w * 3 + i) + lane, row = u / 24, pos = u % 24, ch = (pos & ~7) | ((pos & 7) ^ ((row >> 1) & 7)); koff[i] = (unsigned)(row * 6144 + ch * 16); }
#pragma unroll
    for (int i = 0; i < 2; ++i) { const int u = 64 * (w * 2 + i) + lane, d = u >> 3, pos = u & 7, ch = pos ^ ((d >> 1) & 7); voff[i] = (unsigned)(d * (VPITCH * 2) + ch * 16); }
    int kaddr[4], vaddr[4];
    { const int pr = pi32(qi), swk = (pr >> 1) & 7, swv = (qi >> 1) & 7;
#pragma unroll
      for (int j = 0; j < 4; ++j) { kaddr[j] = pr * 384 + 16 * ((2 * j + g) ^ swk); vaddr[j] = KBYTES + qi * 128 + 16 * ((2 * j + g) ^ swv); } }
    const unsigned ldsbase = (unsigned)(size_t)lds;
#define MLA_DMA(kt, bufoff) do { const unsigned char* _kb = uni_ptr(kbase + (size_t)(kt) * (64 * 6144)); const unsigned char* _vb = uni_ptr(vbase + (size_t)(kt) * 128); const unsigned _l = ldsbase + (unsigned)(bufoff); \
        _Pragma("unroll") for (int _i = 0; _i < 3; ++_i) dma16(_kb, koff[_i], _l + (unsigned)((w * 3 + _i) * 1024)); \
        _Pragma("unroll") for (int _i = 0; _i < 2; ++_i) dma16(_vb, voff[_i], _l + (unsigned)(KBYTES + (w * 2 + _i) * 1024)); } while (0)
    for (int uu0 = blockIdx.x; uu0 < 1024 * (PROBE_PH == 31 ? PROBE_N : 1); uu0 += gridDim.x) {
        const int uu = uu0 & 1023;
        const int kk = uu >> 8, c = uu & 255, bh = c & 31, jj = c >> 5;
        const int qb = kk == 0 ? 31 - jj : kk == 1 ? 16 + jj : kk == 2 ? 15 - jj : jj;
        const int b = bh >> 4, h = bh & 15;
        const int r0 = qb * 256 + w * 32;
        const unsigned char* kbase = k192 + ((size_t)(b * S) * 16 + h) * 384;
        const unsigned char* vbase = vt + (size_t)(bh * 128) * (VPITCH * 2);
        const int nkt = 4 * (qb + 1);
        MLA_DMA(0, 0); MLA_DMA(1, BUF);
        bf16x8 qf[12];
        { const bf16_t* qrow = q + (size_t)(b * S + r0 + qi) * QW;
#pragma unroll
          for (int ks = 0; ks < 8; ++ks) qf[ks] = *(const bf16x8*)(qrow + h * 128 + ks * 16 + g * 8);
#pragma unroll
          for (int ks = 0; ks < 4; ++ks) qf[8 + ks] = *(const bf16x8*)(qrow + 2048 + h * 64 + ks * 16 + g * 8); }
        f32x16 oacc[4];
#pragma unroll
        for (int i = 0; i < 4; ++i) oacc[i] = zero16();
        float m_run = NINF, l_run = 0.f;
#pragma unroll
        for (int ks = 0; ks < 12; ++ks) asm volatile("" :: "v"(qf[ks]));
        asm volatile("s_waitcnt vmcnt(0)" ::: "memory"); __syncthreads();
#define MLA_QK(KA, IMM, sacc_) do { \
        bf16x8 fa[4], fb[4]; \
        _Pragma("unroll") for (int j = 0; j < 4; ++j) fa[j] = *(const LAS bf16x8*)(lds + KA[j] + (IMM)); \
        _Pragma("unroll") for (int j = 0; j < 4; ++j) fb[j] = *(const LAS bf16x8*)(lds + KA[j] + (IMM) + 128); \
        __builtin_amdgcn_sched_barrier(0); \
        __builtin_amdgcn_s_setprio(1); \
        _Pragma("unroll") for (int gi = 0; gi < 6; gi += 2) { \
            _Pragma("unroll") for (int j = 0; j < 4; ++j) sacc_[gi / 3] = MFMA32(fa[j], qf[4 * (gi % 3) + j], sacc_[gi / 3]); \
            if (gi + 2 < 6) { _Pragma("unroll") for (int j = 0; j < 4; ++j) fa[j] = *(const LAS bf16x8*)(lds + KA[j] + (IMM) + 128 * ((gi + 2) % 3) + 12288 * ((gi + 2) / 3)); } \
            __builtin_amdgcn_sched_barrier(0); \
            _Pragma("unroll") for (int j = 0; j < 4; ++j) sacc_[(gi + 1) / 3] = MFMA32(fb[j], qf[4 * ((gi + 1) % 3) + j], sacc_[(gi + 1) / 3]); \
            if (gi + 3 < 6) { _Pragma("unroll") for (int j = 0; j < 4; ++j) fb[j] = *(const LAS bf16x8*)(lds + KA[j] + (IMM) + 128 * ((gi + 3) % 3) + 12288 * ((gi + 3) / 3)); } \
            __builtin_amdgcn_sched_barrier(0); \
        } \
        __builtin_amdgcn_s_setprio(0); } while (0)
#define MLA_SMPV(VA, IMM, sacc_, kt_) do { \
        if (64 * (kt_) + 63 > r0) { \
            const int qrow = r0 + qi; \
            _Pragma("unroll") for (int kb = 0; kb < 2; ++kb) \
            _Pragma("unroll") for (int e = 0; e < 16; ++e) { const int key = 64 * (kt_) + kb * 32 + 16 * (e >> 3) + 8 * g + (e & 7); if (key > qrow) sacc_[kb][e] = NINF; } \
        } \
        float mx0 = NINF, mx1 = NINF, mx2 = NINF, mx3 = NINF;        \
        _Pragma("unroll") for (int kb = 0; kb < 2; ++kb) \
        _Pragma("unroll") for (int e = 0; e < 16; e += 4) { mx0 = fmaxf(mx0, sacc_[kb][e]); mx1 = fmaxf(mx1, sacc_[kb][e + 1]); mx2 = fmaxf(mx2, sacc_[kb][e + 2]); mx3 = fmaxf(mx3, sacc_[kb][e + 3]); } \
        float mx = fmaxf(fmaxf(mx0, mx1), fmaxf(mx2, mx3)); \
        mx = xhalf_max(mx); \
          \
          \
        float alpha = 1.0f; \
        if (__builtin_amdgcn_ballot_w64((mx - m_run) > 8.0f) != 0ull) { \
            const float m_new = fmaxf(m_run, mx); \
            alpha = fast_exp2(m_run - m_new); \
            m_run = m_new; \
            _Pragma("unroll") for (int db = 0; db < 4; ++db) \
            _Pragma("unroll") for (int e = 0; e < 16; ++e) oacc[db][e] *= alpha; \
        } \
        float ls0 = 0.f, ls1 = 0.f, ls2 = 0.f, ls3 = 0.f;        \
        _Pragma("unroll") for (int kb = 0; kb < 2; ++kb) \
        _Pragma("unroll") for (int e = 0; e < 16; ++e) { const float p = fast_exp2(sacc_[kb][e] - m_run); sacc_[kb][e] = p; \
            if ((e & 3) == 0) ls0 += p; else if ((e & 3) == 1) ls1 += p; else if ((e & 3) == 2) ls2 += p; else ls3 += p; } \
        l_run = l_run * alpha + ((ls0 + ls1) + (ls2 + ls3)); \
        _Pragma("unroll") for (int kb = 0; kb < 2; ++kb) \
        _Pragma("unroll") for (int s2 = 0; s2 < 2; ++s2) { \
            const bf16x8 pf = packp(sacc_[kb], s2); \
            _Pragma("unroll") for (int db = 0; db < 4; ++db) oacc[db] = MFMA32(*(const LAS bf16x8*)(lds + VA[kb * 2 + s2] + (IMM) + 4096 * db), pf, oacc[db]); \
        } } while (0)
#define MLA_INTERVAL(KA, VA, kp_, NB) do { \
        { f32x16 sacc[2]; sacc[0] = zero16(); sacc[1] = zero16(); \
          if (64 * (kp_) <= r0) { MLA_QK(KA, 0, sacc); MLA_SMPV(VA, 0, sacc, (kp_)); } } \
        if ((kp_) + 2 < nkt) { MLA_DMA((kp_) + 2, (NB)); MLA_DMA((kp_) + 3, (NB) + BUF); } \
        { f32x16 sacc[2]; sacc[0] = zero16(); sacc[1] = zero16(); \
          if (64 * ((kp_) + 1) <= r0) { MLA_QK(KA, BUF, sacc); MLA_SMPV(VA, BUF, sacc, (kp_) + 1); } } \
        asm volatile("s_waitcnt vmcnt(0)" ::: "memory"); __syncthreads(); } while (0)
        int kaddrH[4], vaddrH[4];
#pragma unroll
        for (int j = 0; j < 4; ++j) { kaddrH[j] = kaddr[j] + 2 * BUF; vaddrH[j] = vaddr[j] + 2 * BUF; }
#pragma unroll 1
        for (int kp = 0; kp < nkt; kp += 4) {
            MLA_INTERVAL(kaddr, vaddr, kp, 2 * BUF);
            MLA_INTERVAL(kaddrH, vaddrH, kp + 2, 0);
        }
#undef MLA_QK
#undef MLA_SMPV
#undef MLA_INTERVAL
        const float l = l_run + __shfl_xor(l_run, 32);
        const float inv = 1.0f / l;
        float sq = 0.f;
        bf16_t* orow = mixed + (size_t)(b * S + r0 + qi) * D + h * 128 + 8 * g;
#pragma unroll
        for (int db = 0; db < 4; ++db)
#pragma unroll
            for (int t2 = 0; t2 < 2; ++t2) {
                unsigned wa[2], wb[2];
#pragma unroll
                for (int q2 = 0; q2 < 2; ++q2) {
                    const int j4 = 2 * t2 + q2;
                    const float o0 = oacc[db][4 * j4] * inv, o1 = oacc[db][4 * j4 + 1] * inv, o2 = oacc[db][4 * j4 + 2] * inv, o3 = oacc[db][4 * j4 + 3] * inv;
                    sq += (o0 * o0 + o1 * o1) + (o2 * o2 + o3 * o3);
                    if (q2 == 0) { wa[0] = pk2(o0, o1); wa[1] = pk2(o2, o3); } else { wb[0] = pk2(o0, o1); wb[1] = pk2(o2, o3); }
                }
                const auto rx = __builtin_amdgcn_permlane32_swap(wa[0], wb[0], false, false);
                const auto ry = __builtin_amdgcn_permlane32_swap(wa[1], wb[1], false, false);
                u32x4 wv; wv.x = rx[0]; wv.y = ry[0]; wv.z = rx[1]; wv.w = ry[1];
                *(u32x4*)(orow + 32 * db + 16 * t2) = wv;
            }
        sq += __shfl_xor(sq, 32);
        if (g == 0) unsafeAtomicAdd(ssqA + (uu0 >= 1024 ? 6 * T : 0) + b * S + r0 + qi, sq);
    }
#undef MLA_DMA
}

DI void swa_phase(const Ptrs& P, LAS unsigned char* lds, float* ssqbase) {
    unsigned char* ws = P.ws;
    const bf16_t* proj = (const bf16_t*)(ws + WS_PROJ); const bf16_t* vts = (const bf16_t*)(ws + WS_VTS);
    bf16_t* mixed = (bf16_t*)(ws + WS_R0); float* ssqB = ssqbase + 3 * T;
    const int tid = my_tid(), lane = tid & 63, w = __builtin_amdgcn_readfirstlane(tid >> 6), qi = lane & 31, g = lane >> 5;
    constexpr int KST = 144, VST = 528, KBYTES = 256 * KST, VBYTES = 64 * VST;
    LAS float* POS = (LAS float*)(lds + KBYTES + VBYTES);
    const float NINF = -__builtin_inff();
    for (int uu0 = blockIdx.x; uu0 < 2048 * (PROBE_PH == 32 ? PROBE_N : 1); uu0 += gridDim.x) {
        const int uu = uu0 & 2047;
        const int hp = uu & 3, gk = (uu >> 2) & 3, n = (uu >> 4) & 63, b = uu >> 10;
        const int key_base = (n - 1) * 128;
        __syncthreads();
#pragma unroll
        for (int i = 0; i < 4; ++i) {
            const int id = tid + 512 * i;
            { const int kl = id >> 3, ch = id & 7, key = key_base + kl, keyc = key < 0 ? 0 : key;
              u32x4 v = *(const u32x4*)(proj + (size_t)(b * S + keyc) * DIN_P + PJ_KS + gk * 64 + ch * 8);
              if (key < 0) v = (u32x4){0u, 0u, 0u, 0u};
              *(LAS u32x4*)(lds + kl * KST + ch * 16) = v; }
            { const int d = id >> 5, ch = id & 31, key = key_base + ch * 8, keyc = key < 0 ? 0 : key;
              u32x4 v = *(const u32x4*)(vts + (size_t)((b * 4 + gk) * 64 + d) * VPITCH + keyc);
              if (key < 0) v = (u32x4){0u, 0u, 0u, 0u};
              *(LAS u32x4*)(lds + KBYTES + d * VST + ch * 16) = v; }
        }
        if (tid < 256) { const int key = key_base + tid, keyc = key < 0 ? 0 : key; const float pv = (float)P.pos[b * S + keyc]; POS[tid] = key >= 0 ? pv : 0.f; }
        __syncthreads();
        const int head = gk * 8 + hp * 2 + (w >> 2), wq = w & 3, qoff = wq * 32;
        const int trow = b * S + n * 128 + qoff + qi;
        bf16x8 qf[4];
#pragma unroll
        for (int ks = 0; ks < 4; ++ks) qf[ks] = *(const bf16x8*)(proj + (size_t)trow * DIN_P + PJ_QS + head * 64 + ks * 16 + g * 8);
        const float posq = (float)P.pos[trow];
        const float slope2 = fast_exp2(-0.25f * (float)(head + 1)) * LOG2E;
        const float sink2 = P.sinks[head] * LOG2E;
        f32x16 sacc[5];
#pragma unroll
        for (int t = 0; t < 5; ++t) {
            const int kb = wq + t;
            const LAS unsigned char* kp = lds + (kb * 32 + pi32(qi)) * KST + g * 16;
            f32x16 a = zero16();
#pragma unroll
            for (int ks = 0; ks < 4; ++ks) a = MFMA32(*(const LAS bf16x8*)(kp + ks * 32), qf[ks], a);
            sacc[t] = a;
            __builtin_amdgcn_sched_barrier(0);
        }
        float mx = sink2;
#pragma unroll
        for (int t = 0; t < 5; ++t) {
            const int kb = wq + t;
            const bool padblk = (n == 0) && (kb < 4);
#pragma unroll
            for (int hh = 0; hh < 2; ++hh) {
                const int kl0 = kb * 32 + 16 * hh + 8 * g;
                const f32x4 pa = *(const LAS f32x4*)(POS + kl0), pb = *(const LAS f32x4*)(POS + kl0 + 4);
#pragma unroll
                for (int e = 0; e < 8; ++e) {
                    const int kll = 16 * hh + 8 * g + e;
                    const float pk = e < 4 ? pa[e & 3] : pb[e & 3];
                    float sv = sacc[t][8 * hh + e] - slope2 * fabsf(posq - pk);
                    bool valid = !padblk;
                    if (t == 0) valid = valid && (kll > qi);
                    if (t == 4) valid = valid && (kll <= qi);
                    sv = valid ? sv : NINF;
                    sacc[t][8 * hh + e] = sv; mx = fmaxf(mx, sv);
                }
            }
        }
        mx = xhalf_max(mx);
        float lsum = 0.f;
#pragma unroll
        for (int t = 0; t < 5; ++t)
#pragma unroll
            for (int e = 0; e < 16; ++e) { const float p = fast_exp2(sacc[t][e] - mx); sacc[t][e] = p; lsum += p; }
        f32x16 oacc[2]; oacc[0] = zero16(); oacc[1] = zero16();
#pragma unroll
        for (int t = 0; t < 5; ++t) {
            const int kb = wq + t;
#pragma unroll
            for (int s2 = 0; s2 < 2; ++s2) {
                const bf16x8 pf = packp(sacc[t], s2);
#pragma unroll
                for (int db = 0; db < 2; ++db) {
                    const LAS unsigned char* vp = lds + KBYTES + (32 * db + qi) * VST + (kb * 32 + 16 * s2 + 8 * g) * 2;
                    oacc[db] = MFMA32(*(const LAS bf16x8*)vp, pf, oacc[db]);
                }
                __builtin_amdgcn_sched_barrier(0);
            }
        }
        const float l = lsum + __shfl_xor(lsum, 32) + fast_exp2(sink2 - mx);
        const float inv = 1.0f / l;
        float sq = 0.f;
        bf16_t* orow = mixed + (size_t)trow * D + 2048 + head * 64 + 4 * g;
#pragma unroll
        for (int db = 0; db < 2; ++db)
#pragma unroll
            for (int j4 = 0; j4 < 4; ++j4) {
                const float o0 = oacc[db][4 * j4] * inv, o1 = oacc[db][4 * j4 + 1] * inv, o2 = oacc[db][4 * j4 + 2] * inv, o3 = oacc[db][4 * j4 + 3] * inv;
                sq += (o0 * o0 + o1 * o1) + (o2 * o2 + o3 * o3);
                u32x2 wv; wv.x = pk2(o0, o1); wv.y = pk2(o2, o3);
                *(u32x2*)(orow + 32 * db + 8 * j4) = wv;
            }
        sq += __shfl_xor(sq, 32);
        if (g == 0) unsafeAtomicAdd(ssqB + (uu0 >= 2048 ? 6 * T : 0) + trow, sq);
    }
}

DI void norm_mixed_phase(const Ptrs& P) {
    unsigned char* ws = P.ws; bf16_t* mixed = (bf16_t*)(ws + WS_R0);
    const float* ssqA = (const float*)(ws + WS_SSQ) + 2 * T; const float* ssqB = ssqA + T;
    const int tid = my_tid(), lane = tid & 63, gw = blockIdx.x * 8 + (tid >> 6), NGW = gridDim.x * 8;
    for (int row = gw; row < T; row += NGW) {
        const float rsA = rsqrtf(ssqA[row] * (1.0f / 2048.0f) + EPS), rsB = rsqrtf(ssqB[row] * (1.0f / 2048.0f) + EPS);
        u32x4* mp = (u32x4*)(mixed + (size_t)row * D) + lane;
#pragma unroll
        for (int j = 0; j < 8; ++j) {
            const int col0 = (lane + 64 * j) * 8; const bool hb = col0 >= 2048;
            const float rs = hb ? rsB : rsA; const float* gp = hb ? P.g_swa + (col0 - 2048) : P.g_mla + col0;
            const f32x4 g0 = *(const f32x4*)gp, g1 = *(const f32x4*)(gp + 4);
            const u32x4 v = mp[64 * j]; u32x4 o;
            o.x = pk2(bflo(v.x) * rs * g0[0], bfhi(v.x) * rs * g0[1]); o.y = pk2(bflo(v.y) * rs * g0[2], bfhi(v.y) * rs * g0[3]);
            o.z = pk2(bflo(v.z) * rs * g1[0], bfhi(v.z) * rs * g1[1]); o.w = pk2(bflo(v.w) * rs * g1[2], bfhi(v.w) * rs * g1[3]);
            mp[64 * j] = o;
        }
    }
}
DI void x1_phase(const Ptrs& P) {
    unsigned char* ws = P.ws; const bf16_t* y = (const bf16_t*)(ws + WS_Y); const float* ssq_y = (const float*)(ws + WS_SSQ) + 4 * T; bf16_t* h2 = (bf16_t*)(ws + WS_R0);
    const int tid = my_tid(), lane = tid & 63, gw = blockIdx.x * 8 + (tid >> 6), NGW = gridDim.x * 8;
    for (int row = gw; row < T; row += NGW) {
        const float rsy = rsqrtf(ssq_y[row] * (1.0f / D) + EPS);
        const f32x4* xr = (const f32x4*)(P.x + (size_t)row * D) + lane; const u32x2* yr = (const u32x2*)(y + (size_t)row * D) + lane;
        const f32x4* gp = (const f32x4*)P.g_attn_post + lane; u32x2* op = (u32x2*)((bf16_t*)P.out + (size_t)row * D) + lane;
        f32x4 v[16]; float s = 0.f;
#pragma unroll
        for (int hb = 0; hb < 2; ++hb) {
            f32x4 a[8], gg[8]; u32x2 yb[8];
#pragma unroll
            for (int j = 0; j < 8; ++j) { a[j] = xr[64 * (8 * hb + j)]; gg[j] = gp[64 * (8 * hb + j)]; yb[j] = yr[64 * (8 * hb + j)]; }
#pragma unroll
            for (int j = 0; j < 8; ++j) { const f32x4 bq = {bflo(yb[j].x), bfhi(yb[j].x), bflo(yb[j].y), bfhi(yb[j].y)};
                const f32x4 r = a[j] + bq * rsy * gg[j]; v[8 * hb + j] = r; u32x2 xb; xb.x = pk2(r[0], r[1]); xb.y = pk2(r[2], r[3]); op[64 * (8 * hb + j)] = xb;
                s += (r[0] * r[0] + r[1] * r[1]) + (r[2] * r[2] + r[3] * r[3]); }
        }
        const f32x4* g2 = (const f32x4*)P.g_ffn_pre + lane;
        f32x4 g2v[16];
#pragma unroll
        for (int j = 0; j < 16; ++j) g2v[j] = g2[64 * j];
        const float rs = rsqrtf(wave_sum(s) * (1.0f / D) + EPS);
        u32x2* o = (u32x2*)(h2 + (size_t)row * D) + lane;
#pragma unroll
        for (int j = 0; j < 16; ++j) { const f32x4 gg = g2v[j]; u32x2 wv; wv.x = pk2(v[j][0] * rs * gg[0], v[j][1] * rs * gg[1]); wv.y = pk2(v[j][2] * rs * gg[2], v[j][3] * rs * gg[3]); o[64 * j] = wv; }
    }
}
DI void x2_phase(const Ptrs& P) {
    unsigned char* ws = P.ws; const bf16_t* f = (const bf16_t*)(ws + WS_F); const float* ssq_f = (const float*)(ws + WS_SSQ) + 5 * T; bf16_t* x2b = (bf16_t*)(ws + WS_X2B);
    const int tid = my_tid(), lane = tid & 63, gw = blockIdx.x * 8 + (tid >> 6), NGW = gridDim.x * 8;
    for (int row = gw; row < T; row += NGW) {
        const float rsf = rsqrtf(ssq_f[row] * (1.0f / D) + EPS);
        const u32x2* fr = (const u32x2*)(f + (size_t)row * D) + lane; const f32x4* gp = (const f32x4*)P.g_ffn_post + lane;
        const u32x2* op = (const u32x2*)((const bf16_t*)P.out + (size_t)row * D) + lane; u32x2* o = (u32x2*)(x2b + (size_t)row * D) + lane;
        u32x2 abv[16], fbv[16]; f32x4 ggv[16];
#pragma unroll
        for (int j = 0; j < 16; ++j) { abv[j] = op[64 * j]; fbv[j] = fr[64 * j]; ggv[j] = gp[64 * j]; }
#pragma unroll
        for (int j = 0; j < 16; ++j) { const u32x2 ab = abv[j]; const f32x4 a = {bflo(ab.x), bfhi(ab.x), bflo(ab.y), bfhi(ab.y)}, gg = ggv[j]; const u32x2 fb = fbv[j]; const f32x4 bq = {bflo(fb.x), bfhi(fb.x), bflo(fb.y), bfhi(fb.y)};
            const f32x4 r = a + bq * rsf * gg;
            u32x2 wv; wv.x = pk2(r[0], r[1]); wv.y = pk2(r[2], r[3]); o[64 * j] = wv; }
    }
}

constexpr int NPHASE = 11;
struct Params { const void* in[21]; float* out; unsigned char* ws; int ph_lo, ph_hi; };

__global__ void __launch_bounds__(512, 2) mk_fwd(Params prm) {
    extern __shared__ __attribute__((aligned(16))) unsigned char lds_raw[];
    LAS unsigned char* lds = (LAS unsigned char*)lds_raw;
#define GPTR(T, i) ((T*)(T __attribute__((address_space(1)))*)kin[i])
#define LOADP() Ptrs P; { const void* kin[23]; _Pragma("unroll") for (int _q = 0; _q < 21; ++_q) kin[_q] = prm.in[_q]; kin[21] = prm.out; kin[22] = prm.ws; \
    P.x = GPTR(const float, 0); P.p = GPTR(const float, 1); P.pos = GPTR(const int, 2); P.g_attn_pre = GPTR(const float, 3); P.w_in = GPTR(const float, 4); \
    P.g_qa = GPTR(const float, 5); P.w_qup = GPTR(const float, 6); P.g_kva = GPTR(const float, 7); P.w_kvup = GPTR(const float, 8); P.sinks = GPTR(const float, 9); \
    P.g_mla = GPTR(const float, 10); P.g_swa = GPTR(const float, 11); P.w_o = GPTR(const float, 12); P.g_attn_post = GPTR(const float, 13); P.g_ffn_pre = GPTR(const float, 14); \
    P.w_gate = GPTR(const float, 15); P.w_up = GPTR(const float, 16); P.w_down = GPTR(const float, 17); P.g_ffn_post = GPTR(const float, 18); \
    P.w_pg = GPTR(const float, 19); P.w_pp = GPTR(const float, 20); P.out = GPTR(float, 21); P.ws = GPTR(unsigned char, 22); \
 } \
    unsigned char* ws = P.ws; float* ssq = (float*)(ws + WS_SSQ); const f32x2* cs = (const f32x2*)(ws + WS_CS); (void)ssq; (void)cs;
    const int lo = prm.ph_lo, hi = prm.ph_hi;
    const int G = gridDim.x, cid = blockIdx.x;
    if (hi - lo > 1) xcd_barrier_post((unsigned*)(prm.ws + WS_KR));
    if (hi > 1000) cg::this_grid().sync();
#define IN(k) (lo <= (k) && (k) < hi)
#define SEAM(k) do { if (IN((k) + 1)) xcd_barrier((unsigned*)(ws + WS_KR)); } while (0)
#define NREP(k) ((PROBE_PH == (k) || (PROBE_PH >= 10 && PROBE_PH / 10 == (k))) ? PROBE_N : 1)
#define REPSYNC(k) do { if (_r + 1 < NREP(k)) cg::this_grid().sync(); } while (0)
    if (IN(0)) { LOADP(); phase0(P, lds); if (PROBE_PH == 0) { cg::this_grid().sync(); phase0(P, lds); } SEAM(0); }
    if (IN(1)) { LOADP();
        for (int _r = 0; _r < NREP(1); ++_r) {
        float* sq = ssq + (_r ? 6 * T : 0);
        { pg8::Gemm g{(const bf16_t*)(ws + WS_R0), (const bf16_t*)(ws + WS_WIN), T, 3840, D, D, D}; pg8::StaticOrder So; So.init(T, 3840, G, cid);
          EpiIn E{(bf16_t*)(ws + WS_PROJ), sq, sq + T, (bf16_t*)(ws + WS_VTS), (bf16_t*)(ws + WS_KN), cs};
          pg8::gemm_phase<EpiIn>(lds, g, So, E); }
        {
            const int t0 = (64 * 15) % G, gp = t0 ? G - t0 : G, cp = t0 ? cid - t0 : cid;
            if (cp >= 0) {
                pg8::Gemm g{(const bf16_t*)(ws + WS_WIN) + (size_t)3840 * D, (const bf16_t*)(ws + WS_R0), 256, T, D, D, D}; pg8::StaticOrder So; So.init(256, T, gp, cp);
                EpiVt E{(bf16_t*)(ws + WS_VTS), 256, nullptr, 0.f};
                pg8::gemm_phase<EpiVt>(lds, g, So, E);
            }
        }
        { pg8::Gemm g{(const bf16_t*)(ws + WS_R0), (const bf16_t*)(ws + WS_WIN) + (size_t)4096 * D, T, 256, 1024, D, D}; pg8::StaticOrder So; So.init(T, 256, G, cid, 2);
          EpiKr E{(float*)(ws + WS_KRP)};
          pg8::gemm_phase<EpiKr>(lds, g, So, E); }
        REPSYNC(1); }
        SEAM(1);
    }
    if (IN(2)) { LOADP();
        kr_phase(P);
        for (int _r = 0; _r < NREP(2); ++_r) {
        { pg8::Gemm g{(const bf16_t*)(ws + WS_PROJ) + PJ_CQ, (const bf16_t*)(ws + WS_WQUP), T, QW, 1024, DIN_P, 1024}; pg8::StaticOrder So; So.init(T, QW, G, cid);
          EpiUp<0> E{ssq, 1.0f / 1024.0f, MLA_QSCALE, (bf16_t*)(ws + WS_Q), QW, cs, nullptr};
          pg8::gemm_phase<EpiUp<0>>(lds, g, So, E); }
        { pg8::Gemm g{(const bf16_t*)(ws + WS_PROJ) + PJ_CKV, (const bf16_t*)(ws + WS_WKVUP), T, 2048, 512, DIN_P, 512}; pg8::StaticOrder So; So.init(T, 2048, G, cid);
          EpiUp<1> E{ssq + T, 1.0f / 512.0f, 1.0f, (bf16_t*)(ws + WS_KN), KNW, cs, nullptr};
          pg8::gemm_phase<EpiUp<1>>(lds, g, So, E); }
        { pg8::Gemm g{(const bf16_t*)(ws + WS_WKVUP) + (size_t)2048 * 512, (const bf16_t*)(ws + WS_PROJ) + PJ_CKV, 2048, T, 512, 512, DIN_P}; pg8::StaticOrder So; So.init(2048, T, G, cid);
          EpiVt E{(bf16_t*)(ws + WS_VT), 2048, ssq + T, 1.0f / 512.0f};
          pg8::gemm_phase<EpiVt>(lds, g, So, E); }
        REPSYNC(2); }
        SEAM(2);
    }
    if (IN(3)) { LOADP();
        mla_phase(P, lds, ssq); swa_phase(P, lds, ssq);
        SEAM(3);
    }
    if (IN(5)) { LOADP();
        for (int _r = 0; _r < NREP(5); ++_r) {
        pg8::Gemm g{(const bf16_t*)(ws + WS_R0), (const bf16_t*)(ws + WS_WO), T, D, 2048, D, D}; pg8::StaticOrder So; So.init(T, D, G, cid, 1);
        EpiBf16Ssq<true> E{(bf16_t*)(ws + WS_Y), ssq + 4 * T + (_r ? 6 * T : 0), ssq + 2 * T, ssq + 3 * T};
        pg8::gemm_phase<EpiBf16Ssq<true>>(lds, g, So, E); REPSYNC(5); }
        SEAM(5);
    }
    if (IN(6)) { LOADP(); for (int _r = 0; _r < NREP(6); ++_r) { x1_phase(P); REPSYNC(6); } SEAM(6); }
    if (IN(7)) { LOADP();
        for (int _r = 0; _r < NREP(7); ++_r) {
        pg8::Gemm g{(const bf16_t*)(ws + WS_R0), (const bf16_t*)(ws + WS_WGU), T, 2 * DFF, D, D, D}; pg8::StaticOrder So; So.init(T, 2 * DFF, G, cid);
        EpiSwiglu E{(bf16_t*)(ws + WS_ACT)};
        pg8::gemm_phase<EpiSwiglu>(lds, g, So, E); REPSYNC(7); }
        {
            const int t0 = (64 * 86) % G, gp = t0 ? G - t0 : G, cp = t0 ? cid - t0 : cid;
            if (cp >= 0) {
                pg8::Gemm g{(const bf16_t*)(ws + WS_PB), (const bf16_t*)(ws + WS_WPP), T, D, PLE, PLE, PLE}; pg8::StaticOrder So; So.init(T, D, gp, cp);
                EpiBf16 E{(bf16_t*)(ws + WS_PP), D};
                pg8::gemm_phase<EpiBf16>(lds, g, So, E);
            }
        }
        SEAM(7);
    }
    if (IN(8)) { LOADP();
        for (int _r = 0; _r < NREP(8); ++_r) {
        pg8::Gemm g{(const bf16_t*)(ws + WS_ACT), (const bf16_t*)(ws + WS_WDN), T, D, DFF, DFF, DFF}; pg8::StaticOrder So; So.init(T, D, G, cid);
        EpiBf16Ssq<false> E{(bf16_t*)(ws + WS_F), ssq + 5 * T + (_r ? 6 * T : 0), nullptr, nullptr};
        pg8::gemm_phase<EpiBf16Ssq<false>>(lds, g, So, E); REPSYNC(8); }
        SEAM(8);
    }
    if (IN(9)) { LOADP(); x2_phase(P); SEAM(9); }
    if (IN(10)) { LOADP();
        { pg8::Gemm g{(const bf16_t*)(ws + WS_X2B), (const bf16_t*)(ws + WS_WPG), T, D, D, D, D}; pg8::StaticOrder So; So.init(T, D, G, cid);
          EpiPle E{P.out, (const bf16_t*)(ws + WS_PP), (const bf16_t*)(ws + WS_X2B)};
          pg8::gemm_phase<EpiPle>(lds, g, So, E); }
    }
#undef IN
#undef SEAM
#undef NREP
#undef REPSYNC
}

extern "C" void kernel_launch(void* const* d_in, const int* in_sizes, int n_in, void* d_out, int out_size, void* d_ws, size_t ws_size, hipStream_t stream) {
    static int grid = 0;
    if (grid == 0) {
        if (n_in != 21 || out_size != T * D || ws_size < WS_TOTAL) { fprintf(stderr, "kernel_launch: unexpected shapes (n_in %d out %d ws %zu)\n", n_in, out_size, ws_size); grid = -1; return; }
        int dev = 0, cus = 0, per_cu = 0;
        hipGetDevice(&dev);
        hipDeviceGetAttribute(&cus, hipDeviceAttributeMultiprocessorCount, dev);
        if (hipFuncSetAttribute((const void*)mk_fwd, hipFuncAttributeMaxDynamicSharedMemorySize, LDS_BYTES) != hipSuccess) { fprintf(stderr, "kernel_launch: hipFuncSetAttribute failed\n"); grid = -1; return; }
        if (hipOccupancyMaxActiveBlocksPerMultiprocessor(&per_cu, (const void*)mk_fwd, 512, LDS_BYTES) != hipSuccess || per_cu < 1) { fprintf(stderr, "kernel_launch: occupancy query says %d\n", per_cu); per_cu = 1; }
        (void)hipGetLastError();
        grid = cus * 1;
        if (grid <= 0) grid = 256;
    }
    if (grid < 0) return;
    Params a{};
    for (int i = 0; i < 21; ++i) a.in[i] = d_in[i];
    a.out = (float*)d_out; a.ws = (unsigned char*)d_ws;
#if MK_SINGLE
    if (hipMemsetAsync((char*)d_ws + WS_KR, 0, 16384, stream) != hipSuccess) { fprintf(stderr, "kernel_launch: hipMemsetAsync failed\n"); return; }
    a.ph_lo = 0; a.ph_hi = NPHASE;
    void* args[] = {&a};
    hipError_t e = hipLaunchCooperativeKernel((const void*)mk_fwd, dim3(grid), dim3(512), args, LDS_BYTES, stream);
    if (e != hipSuccess) fprintf(stderr, "cooperative launch failed: %s (grid %d)\n", hipGetErrorString(e), grid);
#else
    for (int ph = 0; ph < NPHASE; ++ph) {
        a.ph_lo = ph; a.ph_hi = ph + 1;
        hipLaunchKernelGGL(mk_fwd, dim3(grid), dim3(512), LDS_BYTES, stream, a);
    }
#endif
}
```
